# Optimizing an MI355X kernel written in HIP

```python
import jax, jax.numpy as jnp
from jax import lax
import numpy as np

D_MODEL = 2048
BATCH = 4
SEQ = 2048
DEPTH = 2

D_MIX = D_MODEL
D_BRANCH = D_MIX // 4
RWKV_HEAD = 64
RWKV_HEADS = D_BRANCH // RWKV_HEAD
RWKV_LORA_W = 64
RWKV_LORA_A = 64
RWKV_GN_EPS = 64e-5
ATT_HEAD = 64
ATT_Q_HEADS = D_BRANCH // ATT_HEAD
ATT_KV_HEADS = 2
ATT_GROUP = ATT_Q_HEADS // ATT_KV_HEADS
WINDOW = 128
ATT_BLOCK = WINDOW
NEG_INF = -1e30
POOL_WINDOWS = (2, 4, 8, 16)
POOL_GROUPS = len(POOL_WINDOWS)
POOL_CH = D_BRANCH // POOL_GROUPS
SGU_CHUNK = 128
SGU_GROUPS = 4
SGU_CH = D_BRANCH // SGU_GROUPS
LN_EPS = 1e-5
NORM_EPS = 1e-6

A_COLS = 3 * D_BRANCH + RWKV_LORA_W + RWKV_LORA_A
B_COLS = D_BRANCH + 2 * ATT_KV_HEADS * ATT_HEAD
C_COLS = D_BRANCH
D_COLS = 2 * D_BRANCH
G_COLS = D_MIX
D_IN = A_COLS + B_COLS + C_COLS + D_COLS + G_COLS
SPLITS = (A_COLS, A_COLS + B_COLS, A_COLS + B_COLS + C_COLS, A_COLS + B_COLS + C_COLS + D_COLS)

kernel_name = 'hybrid_parallel_rwkv7_swa_pool_sgu'


def rms_norm(x, w):
    xf = x.astype(jnp.float32)
    y = xf * lax.rsqrt(jnp.mean(xf * xf, axis=-1, keepdims=True) + NORM_EPS)
    return (y * w.astype(jnp.float32)).astype(x.dtype)


def token_shift(z, mu):
    z_prev = jnp.pad(z, ((0, 0), (1, 0), (0, 0)))[:, :-1]
    return z + mu * (z_prev - z)


def rwkv7_mixer(z, w0, w_up, a0, a_up, k_k, k_a, r_k, ln_w, ln_b):
    B_, T, _ = z.shape
    H, N = RWKV_HEADS, RWKV_HEAD
    zf = z.astype(jnp.float32)
    r, k, v, wd, ad = jnp.split(zf, [D_BRANCH, 2 * D_BRANCH, 3 * D_BRANCH, 3 * D_BRANCH + RWKV_LORA_W], axis=-1)
    w_log = -jax.nn.softplus(-(w0 + jnp.tanh(wd) @ w_up)) - 0.5
    decay = jnp.exp(-jnp.exp(w_log))
    a = jax.nn.sigmoid(a0 + ad @ a_up)
    heads = lambda t: t.reshape(B_, T, H, N)
    kk = heads(k * k_k)
    kk = kk / jnp.maximum(jnp.sqrt(jnp.sum(kk * kk, axis=-1, keepdims=True)), 1e-12)
    k = k * (1.0 + (a - 1.0) * k_a)
    r, k, v, decay, a = heads(r), heads(k), heads(v), heads(decay), heads(a)
    a_vec = -kk
    b_vec = kk * a

    def step(S, inp):
        r_t, w_t, k_t, v_t, a_t, b_t = inp
        sa = jnp.einsum('bhij,bhj->bhi', S, a_t)
        S = S * w_t[:, :, None, :] + sa[..., None] * b_t[:, :, None, :] + v_t[..., None] * k_t[:, :, None, :]
        y = jnp.einsum('bhij,bhj->bhi', S, r_t)
        return S, y

    xs = tuple(jnp.moveaxis(t, 1, 0) for t in (r, decay, k, v, a_vec, b_vec))
    S0 = jnp.zeros((B_, H, N, N), jnp.float32)
    _, y = lax.scan(step, S0, xs)
    y = jnp.moveaxis(y, 0, 1)
    mu = jnp.mean(y, axis=-1, keepdims=True)
    var = jnp.mean(jnp.square(y - mu), axis=-1, keepdims=True)
    y = ((y - mu) * lax.rsqrt(var + RWKV_GN_EPS)).reshape(B_, T, D_BRANCH) * ln_w + ln_b
    bonus = jnp.sum(r * k * r_k, axis=-1, keepdims=True) * v
    y = y + bonus.reshape(B_, T, D_BRANCH)
    return y.astype(z.dtype)


def alibi_slopes(n_heads):
    return jnp.exp2(-8.0 * (jnp.arange(n_heads) + 1) / n_heads).astype(jnp.float32)


def swa_sink_attention(z, sinks):
    B_, T, _ = z.shape
    NB = T // ATT_BLOCK
    KV, G, HD, BLK = ATT_KV_HEADS, ATT_GROUP, ATT_HEAD, ATT_BLOCK
    zf = z.astype(jnp.float32)
    q, k, v = jnp.split(zf, [D_BRANCH, D_BRANCH + KV * HD], axis=-1)
    q = q.reshape(B_, NB, BLK, KV, G, HD)
    k = k.reshape(B_, NB, BLK, KV, HD)
    v = v.reshape(B_, NB, BLK, KV, HD)

    def with_prev(t):
        prev = jnp.pad(t, ((0, 0), (1, 0), (0, 0), (0, 0), (0, 0)))[:, :-1]
        return jnp.concatenate([prev, t], axis=2)

    kw, vw = with_prev(k), with_prev(v)
    s = jnp.einsum('bnqkgd,bnskd->bnkgqs', q, kw) * (HD ** -0.5)
    qi = jnp.arange(BLK)[:, None]
    sj = jnp.arange(2 * BLK)[None, :]
    dist = qi + BLK - sj
    kpos = jnp.arange(NB)[:, None, None] * BLK + sj[None] - BLK
    valid = (dist >= 0)[None] & (dist < WINDOW)[None] & (kpos >= 0)
    slopes = alibi_slopes(ATT_Q_HEADS).reshape(KV, G)
    s = s - slopes[:, :, None, None] * dist.astype(jnp.float32)
    s = jnp.where(valid[None, :, None, None], s, NEG_INF)
    sink = jnp.broadcast_to(sinks.astype(jnp.float32).reshape(KV, G)[None, None, :, :, None, None], s.shape[:-1] + (1,))
    p = jax.nn.softmax(jnp.concatenate([s, sink], axis=-1), axis=-1)[..., :-1]
    o = jnp.einsum('bnkgqs,bnskd->bnqkgd', p, vw)
    return o.reshape(B_, T, D_BRANCH).astype(z.dtype)


def pool_mixer(z, pool_w, pool_scale):
    B_, T, _ = z.shape
    zg = z.astype(jnp.float32).reshape(B_, T, POOL_GROUPS, POOL_CH)
    csum = jnp.cumsum(zg, axis=1)
    pos = jnp.arange(T) + 1
    outs = []
    for g, w in enumerate(POOL_WINDOWS):
        c = csum[:, :, g]
        lag = jnp.pad(c, ((0, 0), (w, 0), (0, 0)))[:, :T]
        cnt = jnp.minimum(pos, w).astype(jnp.float32)[None, :, None]
        outs.append((c - lag) / cnt - zg[:, :, g])
    pooled = jnp.stack(outs, axis=2)
    y = jnp.einsum('btgc,gcd->btgd', pooled, pool_w)
    return (y.reshape(B_, T, D_BRANCH) * pool_scale).astype(z.dtype)


def spatial_gating(z, norm_w, sgu_w, sgu_b):
    B_, T, _ = z.shape
    NC = T // SGU_CHUNK
    zf = jax.nn.gelu(z.astype(jnp.float32), approximate=False)
    u, v = jnp.split(zf, 2, axis=-1)
    mu = jnp.mean(v, axis=-1, keepdims=True)
    var = jnp.mean(jnp.square(v - mu), axis=-1, keepdims=True)
    v = (v - mu) * lax.rsqrt(var + LN_EPS) * norm_w
    v = v.reshape(B_, NC, SGU_CHUNK, SGU_GROUPS, SGU_CH)
    causal = jnp.tril(jnp.ones((SGU_CHUNK, SGU_CHUNK), dtype=bool))
    w_s = jnp.where(causal[None], sgu_w, 0)
    s = jnp.einsum('gij,bcjgd->bcigd', w_s, v) + jnp.swapaxes(sgu_b, 0, 1)[:, :, None]
    return (u * s.reshape(B_, T, D_BRANCH)).astype(z.dtype)


def hybrid_layer(x, pre_w, post_w, w_in, mu, w0, w_up, a0, a_up, k_k, k_a, r_k, ln_w, ln_b,
                 sinks, pool_w, pool_scale, sgu_norm_w, sgu_w, sgu_b, w_out):
    h = rms_norm(x, pre_w)
    proj = h @ w_in
    za, zb, zc, zd, gate = jnp.split(proj, SPLITS, axis=-1)
    ya = rwkv7_mixer(token_shift(za, mu), w0, w_up, a0, a_up, k_k, k_a, r_k, ln_w, ln_b)
    yb = swa_sink_attention(zb, sinks)
    yc = pool_mixer(zc, pool_w, pool_scale)
    yd = spatial_gating(zd, sgu_norm_w, sgu_w, sgu_b)
    y = jnp.concatenate([ya, yb, yc, yd], axis=-1) * jax.nn.silu(gate)
    return x + rms_norm(y @ w_out, post_w)


def setup_inputs(seed: int = 0) -> dict:
    key = jax.random.key(seed)
    ks = jax.random.split(key, 24)
    L = DEPTH
    nrm = lambda k, shape, s: jax.random.normal(k, shape, jnp.float32) * s
    return {
        'x': nrm(ks[0], (BATCH, SEQ, D_MODEL), 1.0),
        'pre_norm_w': 1.0 + nrm(ks[1], (L, D_MODEL), 0.02),
        'post_norm_w': 1.0 + nrm(ks[2], (L, D_MODEL), 0.02),
        'w_in': nrm(ks[3], (L, D_MODEL, D_IN), D_MODEL ** -0.5),
        'shift_mu': jax.random.uniform(ks[4], (L, A_COLS), jnp.float32),
        'rwkv_w0': jax.random.uniform(ks[5], (L, D_BRANCH), jnp.float32, -4.0, 1.0),
        'rwkv_w_up': nrm(ks[6], (L, RWKV_LORA_W, D_BRANCH), 0.1),
        'rwkv_a0': nrm(ks[7], (L, D_BRANCH), 0.1),
        'rwkv_a_up': nrm(ks[8], (L, RWKV_LORA_A, D_BRANCH), 0.1),
        'rwkv_k_k': 0.85 + nrm(ks[9], (L, D_BRANCH), 0.02),
        'rwkv_k_a': 1.0 + nrm(ks[10], (L, D_BRANCH), 0.02),
        'rwkv_r_k': nrm(ks[11], (L, RWKV_HEADS, RWKV_HEAD), 0.1),
        'rwkv_ln_w': 1.0 + nrm(ks[12], (L, D_BRANCH), 0.02),
        'rwkv_ln_b': nrm(ks[13], (L, D_BRANCH), 0.02),
        'attn_sinks': nrm(ks[14], (L, ATT_Q_HEADS), 0.5),
        'pool_w': nrm(ks[15], (L, POOL_GROUPS, POOL_CH, POOL_CH), POOL_CH ** -0.5),
        'pool_scale': 1.0 + nrm(ks[16], (L, D_BRANCH), 0.02),
        'sgu_norm_w': 1.0 + nrm(ks[17], (L, D_BRANCH), 0.02),
        'sgu_w': nrm(ks[18], (L, SGU_GROUPS, SGU_CHUNK, SGU_CHUNK), 0.5 * SGU_CHUNK ** -0.5),
        'sgu_b': 1.0 + nrm(ks[19], (L, SGU_GROUPS, SGU_CHUNK), 0.02),
        'w_out': nrm(ks[20], (L, D_MIX, D_MODEL), D_MIX ** -0.5),
    }


def reference(x, pre_norm_w, post_norm_w, w_in, shift_mu, rwkv_w0, rwkv_w_up, rwkv_a0, rwkv_a_up,
              rwkv_k_k, rwkv_k_a, rwkv_r_k, rwkv_ln_w, rwkv_ln_b, attn_sinks, pool_w, pool_scale,
              sgu_norm_w, sgu_w, sgu_b, w_out):
    h = x
    for l in range(DEPTH):
        h = hybrid_layer(h, pre_norm_w[l], post_norm_w[l], w_in[l], shift_mu[l], rwkv_w0[l], rwkv_w_up[l],
                         rwkv_a0[l], rwkv_a_up[l], rwkv_k_k[l], rwkv_k_a[l], rwkv_r_k[l], rwkv_ln_w[l],
                         rwkv_ln_b[l], attn_sinks[l], pool_w[l], pool_scale[l], sgu_norm_w[l], sgu_w[l],
                         sgu_b[l], w_out[l])
    return h
```

```cpp
#include <hip/hip_runtime.h>
#include <cstdio>
#include <cstdint>
#include <cmath>
#ifndef HOST_TEST
namespace pg8 {
#define PG8_LAS __attribute__((address_space(3)))
typedef unsigned short bf16_t;
typedef short bf16x8 __attribute__((ext_vector_type(8)));
typedef float f32x4 __attribute__((ext_vector_type(4)));
typedef unsigned u32x4 __attribute__((ext_vector_type(4)));
constexpr int BM = 256, BK = 64, HALF = 128, HTB = HALF * BK * 2  , STAGE_BYTES = 8 * HTB, NXCD = 8, WGM = 8;

__host__ __device__ __forceinline__ int lds_byte(int r, int c) { const int st = (r >> 4) * 2 + (c >> 5), rr = r & 15, cc = c & 31, ob = rr * 64 + cc * 2; return st * 1024 + (ob ^ (((ob >> 9) & 1) << 5)); }
__host__ __device__ __forceinline__ void stage_rc(int b, int& R, int& C) { const int st = b / 1024, sb = b % 1024, swz = sb ^ (((sb >> 9) & 1) << 5); R = (st >> 1) * 16 + swz / 64; C = (st & 1) * 32 + (swz % 64) / 2; }
__host__ __device__ __forceinline__ int perm32(int rho) { const int n = rho >> 4, i = rho & 15; return 8 * (i >> 2) + 4 * n + (i & 3); }

struct Unit { int pm, pn; };
struct Gemm { const bf16_t* A; const bf16_t* Bt; int M, N, K; };

struct StaticOrder {
    int nM, nN, nwg, G, c;
    __host__ __device__ void init(int M, int N, int G_, int c_) { nM = M / BM; nN = N / BM; nwg = nM * nN; G = G_; c = c_; }
    __host__ __device__ bool next(int i, Unit& u) const {
        const long L = (long)i * G + c; if (L >= nwg) return false;
        int wgid = (int)L; { const int q = nwg / NXCD, r = nwg % NXCD, xcd = wgid % NXCD, off = wgid / NXCD; wgid = (xcd < r ? xcd * (q + 1) : r * (q + 1) + (xcd - r) * q) + off; }
        const int nig = WGM * nN, gid = wgid / nig, fm = gid * WGM, gsz = (nM - fm) < WGM ? (nM - fm) : WGM;
        u.pm = fm + ((wgid % nig) % gsz); u.pn = (wgid % nig) / gsz; return true;
    }
    __device__ __forceinline__ void a_ready(const Unit&) const {}
    __device__ __forceinline__ void done(const Unit&) const {}
};

__device__ __forceinline__ unsigned cvt_pk_bf16(float lo, float hi) { unsigned r; asm volatile("v_cvt_pk_bf16_f32 %0, %1, %2" : "=v"(r) : "v"(lo), "v"(hi)); return r; }
typedef float f32x2 __attribute__((ext_vector_type(2)));
__device__ __forceinline__ f32x2 gelu_pk(f32x2 v) {
    const f32x2 av = __builtin_elementwise_abs(v), d = av * 0.2316418882f + 1.0f;
    f32x2 t; t.x = __builtin_amdgcn_rcpf(d.x); t.y = __builtin_amdgcn_rcpf(d.y);
    f32x2 q = t * 0.5307027145f + (-0.7265760135f); q = q * t + 0.7107068705f; q = q * t + (-0.142248368f); q = q * t + 0.127414796f; q = q * t;
    const f32x2 s = (v * v) * (-0.72134752044f);
    f32x2 e; e.x = __builtin_amdgcn_exp2f(s.x); e.y = __builtin_amdgcn_exp2f(s.y);
    const f32x2 m = v * (q * e), r = v - m;
    f32x2 o; o.x = v.x < 0.f ? m.x : r.x; o.y = v.y < 0.f ? m.y : r.y; return o;
}

template <int ACT  > struct EpiBf16 {
    static constexpr bool PERM = true, AFTER_DRAIN = false; static_assert(ACT == 0 || ACT == 1, "EpiBf16: ACT is 0 (none) or 1 (gelu_pk)");
    bf16_t* O; int ldc; const float* bias; int split_cols; size_t split_stride; float scale0;
    __device__ __forceinline__ void operator()(const f32x4 (&acc)[2][2][4][2], const Unit& u, int wr, int wc, int fr, int fq) const {
        const int row0 = u.pm * BM + wr * 64 + fr; int colt = u.pn * BM; bf16_t* base = O;
        float sc = 1.f; if (split_cols) { const int t = colt / split_cols; base += (size_t)t * split_stride; colt -= t * split_cols; if (t == 0) sc = scale0; }
        const int col0 = colt + wc * 32 + 8 * fq, bcol0 = u.pn * BM + wc * 32 + 8 * fq;
        f32x4 bv[2][2];
#pragma unroll
        for (int bj = 0; bj < 2; ++bj)
#pragma unroll
            for (int n = 0; n < 2; ++n) bv[bj][n] = bias ? *(const f32x4*)(bias + bcol0 + bj * HALF + 4 * n) : (f32x4){0.f, 0.f, 0.f, 0.f};
#pragma unroll
        for (int ai = 0; ai < 2; ++ai)
#pragma unroll
            for (int m = 0; m < 4; ++m) { bf16_t* rowp = base + (size_t)(row0 + ai * HALF + m * 16) * ldc + col0;
#pragma unroll
                for (int bj = 0; bj < 2; ++bj) { f32x4 v0 = acc[ai][bj][m][0] + bv[bj][0], v1 = acc[ai][bj][m][1] + bv[bj][1];
                    if (ACT == 1) { f32x2 a = gelu_pk((f32x2){v0[0], v0[1]}), b = gelu_pk((f32x2){v0[2], v0[3]}), c = gelu_pk((f32x2){v1[0], v1[1]}), d = gelu_pk((f32x2){v1[2], v1[3]});
                        v0 = (f32x4){a.x, a.y, b.x, b.y}; v1 = (f32x4){c.x, c.y, d.x, d.y}; }
                    v0 = v0 * sc; v1 = v1 * sc; u32x4 w; w.x = cvt_pk_bf16(v0[0], v0[1]); w.y = cvt_pk_bf16(v0[2], v0[3]); w.z = cvt_pk_bf16(v1[0], v1[1]); w.w = cvt_pk_bf16(v1[2], v1[3]);
                    *(u32x4*)(rowp + bj * HALF) = w; } }
    }
};

struct PanelStats {
    unsigned* xbuf;
    unsigned* cnt;
    unsigned* tmo;
    int ntn; float eps;
    unsigned code;
    __device__ __forceinline__ bool run(const f32x4 (&v)[2][2][4][2], const Unit& u, int wr, int wc, int fr, int fq, PG8_LAS unsigned char* lds, int wid, int lane) const {
        typedef float f32x2v __attribute__((ext_vector_type(2)));
        PG8_LAS f32x2v* P = (PG8_LAS f32x2v*)lds;
        PG8_LAS f32x2v* S = (PG8_LAS f32x2v*)(lds + 8192);
        PG8_LAS unsigned* flag = (PG8_LAS unsigned*)(lds + 8192 + 2048);
#pragma unroll
        for (int ai = 0; ai < 2; ++ai)
#pragma unroll
            for (int m = 0; m < 4; ++m) {
                float s = 0.f;
#pragma unroll
                for (int bj = 0; bj < 2; ++bj)
#pragma unroll
                    for (int n = 0; n < 2; ++n) { const f32x4 x = v[ai][bj][m][n]; s += (x[0] + x[1]) + (x[2] + x[3]); }
                s += __shfl_xor(s, 16); s += __shfl_xor(s, 32);
                const float mw = s * (1.0f / 64.0f); float q = 0.f;
#pragma unroll
                for (int bj = 0; bj < 2; ++bj)
#pragma unroll
                    for (int n = 0; n < 2; ++n) { const f32x4 d = v[ai][bj][m][n] - mw; q += (d[0] * d[0] + d[1] * d[1]) + (d[2] * d[2] + d[3] * d[3]); }
                q += __shfl_xor(q, 16); q += __shfl_xor(q, 32);
                if (fq == 0) P[(ai * HALF + wr * 64 + m * 16 + fr) * 4 + wc] = (f32x2v){mw, q};
            }
        asm volatile("s_waitcnt lgkmcnt(0)" ::: "memory"); __builtin_amdgcn_s_barrier(); asm volatile("" ::: "memory");
#if defined(BROKEN_EXCHANGE_NO_WAIT)
#warning BROKEN CONTROL BUILD: the row-statistics exchange does not wait; results are wrong by design
        if (blockIdx.x >= 64) { const long long t0_ = clock64(); while (clock64() - t0_ < 60000) __builtin_amdgcn_s_sleep(8); }
#endif
        const int row = wid * 32 + (lane & 31);
        if (lane < 32) {
            const f32x2v a = P[row * 4 + 0], b = P[row * 4 + 1], c = P[row * 4 + 2], d = P[row * 4 + 3];
            const float mt = (a.x + b.x + c.x + d.x) * 0.25f;
            const float da = a.x - mt, db = b.x - mt, dc = c.x - mt, dd = d.x - mt;
            const float m2 = (a.y + b.y) + (c.y + d.y) + 64.0f * ((da * da + db * db) + (dc * dc + dd * dd));
            unsigned long long* slot = (unsigned long long*)xbuf + ((size_t)(u.pm * BM + row) * 4 + u.pn);
            __hip_atomic_store(slot, ((unsigned long long)__float_as_uint(m2) << 32) | __float_as_uint(mt), __ATOMIC_RELAXED, __HIP_MEMORY_SCOPE_AGENT);
        }
        asm volatile("s_waitcnt vmcnt(0)" ::: "memory");
        if (lane == 0) __hip_atomic_fetch_add(cnt + 64 * u.pm, 1u, __ATOMIC_RELAXED, __HIP_MEMORY_SCOPE_AGENT);
        if (wid == 0) {
            bool dead = false; const unsigned long long t0 = __builtin_amdgcn_s_memrealtime(); const unsigned want = 8u * (unsigned)ntn;
            for (;;) {
#if defined(BROKEN_EXCHANGE_NO_WAIT)
                break;
#endif
                if ((unsigned)__builtin_amdgcn_readfirstlane(__hip_atomic_load(cnt + 64 * u.pm, __ATOMIC_RELAXED, __HIP_MEMORY_SCOPE_AGENT)) >= want) break;
                if (__builtin_amdgcn_s_memrealtime() - t0 > 2000000ull) {
                    if (lane == 0) { unsigned expect = 0u; __hip_atomic_compare_exchange_strong(tmo + 1, &expect, code | (unsigned)(u.pm & 0xff), __ATOMIC_RELAXED, __ATOMIC_RELAXED, __HIP_MEMORY_SCOPE_AGENT);
                                     __hip_atomic_store(tmo, 1u, __ATOMIC_RELAXED, __HIP_MEMORY_SCOPE_AGENT); }
                    dead = true; break; }
                __builtin_amdgcn_s_sleep(2);
            }
            __builtin_amdgcn_fence(__ATOMIC_ACQUIRE, "agent");
            if (lane == 0) flag[0] = dead ? 1u : 0u;
        }
        asm volatile("s_waitcnt vmcnt(0) lgkmcnt(0)" ::: "memory"); __builtin_amdgcn_s_barrier(); asm volatile("" ::: "memory");
        const bool bad = flag[0] != 0u;
        if (lane < 32) {
            const unsigned long long* slot = (const unsigned long long*)xbuf + (size_t)(u.pm * BM + row) * 4; float mt[4], m2[4]; float ms = 0.f;
#pragma unroll
            for (int t = 0; t < 4; ++t) { if (t < ntn) { const unsigned long long w = __hip_atomic_load(slot + t, __ATOMIC_RELAXED, __HIP_MEMORY_SCOPE_AGENT); mt[t] = __uint_as_float((unsigned)w); m2[t] = __uint_as_float((unsigned)(w >> 32)); } else { mt[t] = 0.f; m2[t] = 0.f; } ms += mt[t]; }
            const float mean = ms / (float)ntn; float q = 0.f;
#pragma unroll
            for (int t = 0; t < 4; ++t) if (t < ntn) { const float dm = mt[t] - mean; q += m2[t] + 256.0f * dm * dm; }
            S[row] = (f32x2v){mean, 1.0f / sqrtf(q / (256.0f * (float)ntn) + eps)};
        }
        asm volatile("s_waitcnt lgkmcnt(0)" ::: "memory"); __builtin_amdgcn_s_barrier(); asm volatile("" ::: "memory");
        return bad;
    }
};
struct EpiLnRes {
    static constexpr bool PERM = false, AFTER_DRAIN = true;
    const float* base; float* out; int ldc; const float* bias; PanelStats st; unsigned poison;
    __device__ __forceinline__ void fused(f32x4 (&acc)[2][2][4][2], const Unit& u, int wr, int wc, int fr, int fq, PG8_LAS unsigned char* lds, int wid, int lane) const {
        typedef float f32x2v __attribute__((ext_vector_type(2)));
        const PG8_LAS f32x2v* S = (const PG8_LAS f32x2v*)(lds + 8192);
        const int col0 = u.pn * BM + wc * 32 + 4 * fq;
#pragma unroll
        for (int bj = 0; bj < 2; ++bj)
#pragma unroll
            for (int n = 0; n < 2; ++n) { const f32x4 bv = bias ? *(const f32x4*)(bias + col0 + bj * HALF + n * 16) : (f32x4){0.f, 0.f, 0.f, 0.f};
#pragma unroll
                for (int ai = 0; ai < 2; ++ai)
#pragma unroll
                    for (int m = 0; m < 4; ++m) acc[ai][bj][m][n] += bv; }
        f32x4 pre[4][2][2];
#pragma unroll
        for (int m = 0; m < 4; ++m) { const size_t off = (size_t)(u.pm * BM + wr * 64 + m * 16 + fr) * ldc + col0;
#pragma unroll
            for (int bj = 0; bj < 2; ++bj)
#pragma unroll
                for (int n = 0; n < 2; ++n) pre[m][bj][n] = *(const f32x4*)(base + off + bj * HALF + n * 16); }
        const bool bad = st.run(acc, u, wr, wc, fr, fq, lds, wid, lane) || poison != 0u;
        const float qnan = __builtin_nanf("");
#pragma unroll
        for (int ai = 0; ai < 2; ++ai)
#pragma unroll
            for (int m = 0; m < 4; ++m) { const int r = ai * HALF + wr * 64 + m * 16 + fr; const f32x2v sr = S[r]; const size_t off = (size_t)(u.pm * BM + r) * ldc + col0;
#pragma unroll
                for (int bj = 0; bj < 2; ++bj)
#pragma unroll
                    for (int n = 0; n < 2; ++n) { const f32x4 bs = ai == 0 ? pre[m][bj][n] : *(const f32x4*)(base + off + bj * HALF + n * 16); f32x4 o = bs + (acc[ai][bj][m][n] - sr.x) * sr.y;
                        if (bad) o = (f32x4){qnan, qnan, qnan, qnan}; *(f32x4*)(out + off + bj * HALF + n * 16) = o; }
                if (m & 1) asm volatile("" ::: "memory"); }
    }
};
struct EpiLnResLn {
    static constexpr bool PERM = false, AFTER_DRAIN = true;
    const float* base; float* out; bf16_t* xn; int ldc; const float* bias; PanelStats st1, st2; unsigned poison;
    __device__ __forceinline__ void fused(f32x4 (&acc)[2][2][4][2], const Unit& u, int wr, int wc, int fr, int fq, PG8_LAS unsigned char* lds, int wid, int lane) const {
        typedef float f32x2v __attribute__((ext_vector_type(2))); typedef unsigned u32x2v __attribute__((ext_vector_type(2)));
        const PG8_LAS f32x2v* S = (const PG8_LAS f32x2v*)(lds + 8192);
        const int col0 = u.pn * BM + wc * 32 + 4 * fq;
#pragma unroll
        for (int bj = 0; bj < 2; ++bj)
#pragma unroll
            for (int n = 0; n < 2; ++n) { const f32x4 bv = bias ? *(const f32x4*)(bias + col0 + bj * HALF + n * 16) : (f32x4){0.f, 0.f, 0.f, 0.f};
#pragma unroll
                for (int ai = 0; ai < 2; ++ai)
#pragma unroll
                    for (int m = 0; m < 4; ++m) acc[ai][bj][m][n] += bv; }
        bool bad = st1.run(acc, u, wr, wc, fr, fq, lds, wid, lane) || poison != 0u;
        const float qnan = __builtin_nanf("");
#pragma unroll
        for (int ai = 0; ai < 2; ++ai)
#pragma unroll
            for (int m = 0; m < 4; ++m) { const int r = ai * HALF + wr * 64 + m * 16 + fr; const f32x2v sr = S[r]; const size_t off = (size_t)(u.pm * BM + r) * ldc + col0;
#pragma unroll
                for (int bj = 0; bj < 2; ++bj)
#pragma unroll
                    for (int n = 0; n < 2; ++n) { const f32x4 bs = *(const f32x4*)(base + off + bj * HALF + n * 16); acc[ai][bj][m][n] = bs + (acc[ai][bj][m][n] - sr.x) * sr.y; }
                asm volatile("" : "+v"(acc[ai][0][m][0]), "+v"(acc[ai][0][m][1]), "+v"(acc[ai][1][m][0]), "+v"(acc[ai][1][m][1]));
                if (m & 1) asm volatile("" ::: "memory"); }
        const bool bad1 = bad;
        bad = st2.run(acc, u, wr, wc, fr, fq, lds, wid, lane) || bad;
#pragma unroll
        for (int ai = 0; ai < 2; ++ai)
#pragma unroll
            for (int m = 0; m < 4; ++m) { const int r = ai * HALF + wr * 64 + m * 16 + fr; const f32x2v sr = S[r]; const size_t off = (size_t)(u.pm * BM + r) * ldc + col0;
#pragma unroll
                for (int bj = 0; bj < 2; ++bj)
#pragma unroll
                    for (int n = 0; n < 2; ++n) { const f32x4 x1 = acc[ai][bj][m][n]; *(f32x4*)(out + off + bj * HALF + n * 16) = bad1 ? (f32x4){qnan, qnan, qnan, qnan} : x1;
                        const f32x4 o = (x1 - sr.x) * sr.y; u32x2v w; w.x = cvt_pk_bf16(o[0], o[1]); w.y = cvt_pk_bf16(o[2], o[3]);
                        if (bad) { w.x = 0x7fc07fc0u; w.y = 0x7fc07fc0u; } *(u32x2v*)(xn + off + bj * HALF + n * 16) = w; }
                asm volatile("" ::: "memory"); }
    }
};

template <class Epi, class Sched, bool ALIGN_EPI = false, bool SP2 = false>
__device__ __forceinline__ void gemm_phase(PG8_LAS unsigned char* lds, const Gemm g, const Sched& S, const Epi& E) {
    int tid_ = threadIdx.x; asm volatile("" : "+v"(tid_));
    const int tid = tid_, wid = __builtin_amdgcn_readfirstlane(tid >> 6), lane = tid & 63, wr = wid >> 2, wc = wid & 3, fr = lane & 15, fq = lane >> 4;
    const int K = g.K, nt = K / BK;
    unsigned voffA[2], voffB[2];
#pragma unroll
    for (int i = 0; i < 2; ++i) { int R, C; stage_rc(tid * 16 + i * 8192, R, C); const int Rb = Epi::PERM ? ((R & ~31) + perm32(R & 31)) : R;
        voffA[i] = (unsigned)(R * K + C) * 2u; voffB[i] = (unsigned)(Rb * K + C) * 2u; }
    const size_t kstep = (size_t)(BK * 2);
    const size_t hstep = (size_t)HALF * K * 2;
    const size_t tstep = 2 * hstep;
    const unsigned ldsw = (unsigned)wid * 1024u;
    const int aoff = lds_byte(wr * 64 + fr, fq * 8), boff = lds_byte(wc * 32 + fr, fq * 8);
#define PG8_SA(b, h) (((b) * 2 + (h)) * HTB)
#define PG8_SB(b, h) ((4 + (b) * 2 + (h)) * HTB)
#define PG8_STAGE(bufoff, gbase, voff) do { _Pragma("unroll") for (int _i = 0; _i < 2; ++_i) \
        __builtin_amdgcn_global_load_lds((const unsigned*)((const char*)(gbase) + (voff)[_i]), (PG8_LAS unsigned*)(lds + (bufoff) + ldsw + _i * 8192), 16, 0, 0); } while (0)
#define PG8_LDA(dst, b, h) do { _Pragma("unroll") for (int m = 0; m < 4; ++m) _Pragma("unroll") for (int k = 0; k < 2; ++k) dst[m][k] = *(const PG8_LAS bf16x8*)(lds + PG8_SA(b, h) + aoff + m * 2048 + k * 1024); } while (0)
#define PG8_LDB(dst, b, h) do { _Pragma("unroll") for (int n = 0; n < 2; ++n) _Pragma("unroll") for (int k = 0; k < 2; ++k) dst[n][k] = *(const PG8_LAS bf16x8*)(lds + PG8_SB(b, h) + boff + n * 2048 + k * 1024); } while (0)
#define PG8_MMA(ai, bj, At, Bt) do { __builtin_amdgcn_s_setprio(1); _Pragma("unroll") for (int m = 0; m < 4; ++m) _Pragma("unroll") for (int n = 0; n < 2; ++n) _Pragma("unroll") for (int k = 0; k < 2; ++k) \
        acc[ai][bj][m][n] = __builtin_amdgcn_mfma_f32_16x16x32_bf16(Bt[n][k], At[m][k], acc[ai][bj][m][n], 0, 0, 0); __builtin_amdgcn_s_setprio(0); } while (0)
#define PG8_WAIT_V(n) asm volatile("s_waitcnt vmcnt(" #n ")" ::: "memory")
#define PG8_WAIT_L(n) asm volatile("s_waitcnt lgkmcnt(" #n ")" ::: "memory")
#define PG8_BAR __builtin_amdgcn_s_barrier()
#define PG8_SCHED __builtin_amdgcn_sched_barrier(0)
    Unit cur, nxt; int ui = 0;
    if (!S.next(0, cur)) return;
    f32x4 acc[2][2][4][2];
#pragma unroll
    for (int a = 0; a < 2; ++a)
#pragma unroll
        for (int b = 0; b < 2; ++b)
#pragma unroll
            for (int m = 0; m < 4; ++m)
#pragma unroll
                for (int n = 0; n < 2; ++n) acc[a][b][m][n] = (f32x4){0.f, 0.f, 0.f, 0.f};
    bf16x8 At[4][2], B0[2][2], B1[2][2];
    const char* cA = (const char*)g.A + (size_t)cur.pm * tstep; const char* cB = (const char*)g.Bt + (size_t)cur.pn * tstep;
    S.a_ready(cur);
    if constexpr (SP2) {
        PG8_STAGE(PG8_SB(0, 0), cB, voffB); PG8_STAGE(PG8_SB(0, 1), cB + hstep, voffB); PG8_STAGE(PG8_SA(0, 0), cA, voffA); PG8_STAGE(PG8_SA(0, 1), cA + hstep, voffA);
        if (wr == 1) PG8_BAR;
        PG8_WAIT_V(2); PG8_BAR;
        PG8_STAGE(PG8_SB(1, 0), cB + kstep, voffB); PG8_STAGE(PG8_SA(1, 0), cA + kstep, voffA); PG8_STAGE(PG8_SB(1, 1), cB + hstep + kstep, voffB);
        PG8_WAIT_V(6); PG8_BAR;
    } else {
        PG8_STAGE(PG8_SB(0, 0), cB, voffB); PG8_STAGE(PG8_SA(0, 0), cA, voffA); PG8_STAGE(PG8_SB(0, 1), cB + hstep, voffB); PG8_STAGE(PG8_SA(0, 1), cA + hstep, voffA);
        if (wr == 1) PG8_BAR;
        PG8_WAIT_V(4); PG8_BAR;
        PG8_STAGE(PG8_SB(1, 0), cB + kstep, voffB); PG8_STAGE(PG8_SA(1, 0), cA + kstep, voffA); PG8_STAGE(PG8_SB(1, 1), cB + hstep + kstep, voffB);
        PG8_WAIT_V(6); PG8_BAR;
    }
    for (;;) {
        const bool has_next = S.next(ui + 1, nxt);
        const char* nA = has_next ? (const char*)g.A + (size_t)nxt.pm * tstep : cA; const char* nB = has_next ? (const char*)g.Bt + (size_t)nxt.pn * tstep : cB;
        for (int t = 0; t < nt; t += 2) {
            const bool last = (t == nt - 2);
            const char* a1 = cA + (size_t)(t + 1) * kstep;
            const char* a2 = last ? nA : cA + (size_t)(t + 2) * kstep; const char* b2 = last ? nB : cB + (size_t)(t + 2) * kstep;
            const char* a3 = a2 + kstep; const char* b3 = b2 + kstep;
            if (last && has_next) S.a_ready(nxt);
            if constexpr (SP2) {
            PG8_LDB(B0, 0, 0); PG8_LDB(B1, 0, 1); PG8_SCHED; PG8_LDA(At, 0, 0); PG8_STAGE(PG8_SA(1, 1), a1 + hstep, voffA);
            PG8_WAIT_V(8); PG8_WAIT_L(0); PG8_BAR; PG8_MMA(0, 0, At, B0); PG8_MMA(0, 1, At, B1); PG8_BAR; PG8_SCHED;
            PG8_LDA(At, 0, 1); PG8_STAGE(PG8_SB(0, 0), b2, voffB); PG8_STAGE(PG8_SB(0, 1), b2 + hstep, voffB); PG8_STAGE(PG8_SA(0, 0), a2, voffA);
            PG8_WAIT_V(8); PG8_WAIT_L(0); PG8_BAR; PG8_MMA(1, 0, At, B0); PG8_MMA(1, 1, At, B1); PG8_BAR; PG8_SCHED;
            PG8_LDB(B0, 1, 0); PG8_LDB(B1, 1, 1); PG8_SCHED; PG8_LDA(At, 1, 0); PG8_STAGE(PG8_SA(0, 1), a2 + hstep, voffA);
            PG8_WAIT_V(8); PG8_WAIT_L(0); PG8_BAR; PG8_MMA(0, 0, At, B0); PG8_MMA(0, 1, At, B1); PG8_BAR; PG8_SCHED;
            PG8_LDA(At, 1, 1); PG8_STAGE(PG8_SB(1, 0), b3, voffB); PG8_STAGE(PG8_SB(1, 1), b3 + hstep, voffB); PG8_STAGE(PG8_SA(1, 0), a3, voffA);
            PG8_WAIT_V(8); PG8_WAIT_L(0); PG8_BAR; PG8_MMA(1, 0, At, B0); PG8_MMA(1, 1, At, B1); PG8_BAR; PG8_SCHED;
            } else {
            PG8_LDB(B0, 0, 0); PG8_SCHED; PG8_LDA(At, 0, 0); PG8_STAGE(PG8_SA(1, 1), a1 + hstep, voffA);
            PG8_WAIT_L(8); PG8_BAR; PG8_WAIT_L(0); PG8_MMA(0, 0, At, B0); PG8_BAR; PG8_SCHED;
            PG8_LDB(B1, 0, 1); PG8_STAGE(PG8_SB(0, 0), b2, voffB);
            PG8_BAR; PG8_WAIT_L(0); PG8_MMA(0, 1, At, B1); PG8_BAR;
            PG8_LDA(At, 0, 1); PG8_STAGE(PG8_SA(0, 0), a2, voffA);
            PG8_BAR; PG8_WAIT_L(0); PG8_MMA(1, 0, At, B0); PG8_BAR; PG8_SCHED;
            PG8_STAGE(PG8_SB(0, 1), b2 + hstep, voffB);
            PG8_WAIT_V(6); PG8_BAR; PG8_MMA(1, 1, At, B1); PG8_BAR;
            PG8_LDB(B0, 1, 0); PG8_SCHED; PG8_LDA(At, 1, 0); PG8_STAGE(PG8_SA(0, 1), a2 + hstep, voffA);
            PG8_WAIT_L(8); PG8_BAR; PG8_WAIT_L(0); PG8_MMA(0, 0, At, B0); PG8_BAR; PG8_SCHED;
            PG8_LDB(B1, 1, 1); PG8_STAGE(PG8_SB(1, 0), b3, voffB);
            PG8_BAR; PG8_WAIT_L(0); PG8_MMA(0, 1, At, B1); PG8_BAR;
            PG8_LDA(At, 1, 1); PG8_STAGE(PG8_SA(1, 0), a3, voffA);
            PG8_BAR; PG8_WAIT_L(0); PG8_MMA(1, 0, At, B0); PG8_BAR; PG8_SCHED;
            PG8_STAGE(PG8_SB(1, 1), b3 + hstep, voffB);
            PG8_WAIT_V(6); PG8_BAR; PG8_MMA(1, 1, At, B1); PG8_BAR;
            }
        }
        if constexpr (ALIGN_EPI) { if (wr == 0) PG8_BAR; }
        if constexpr (!Epi::AFTER_DRAIN) { E(acc, cur, wr, wc, fr, fq); S.done(cur); }
        if (!has_next) break;
#pragma unroll
        for (int a = 0; a < 2; ++a)
#pragma unroll
            for (int b = 0; b < 2; ++b)
#pragma unroll
                for (int m = 0; m < 4; ++m)
#pragma unroll
                    for (int n = 0; n < 2; ++n) acc[a][b][m][n] = (f32x4){0.f, 0.f, 0.f, 0.f};
        cur = nxt; cA = nA; cB = nB; ++ui;
        if constexpr (ALIGN_EPI) { if (wr == 1) PG8_BAR; }
    }
    PG8_WAIT_V(0);
    if constexpr (!ALIGN_EPI) { if (wr == 0) PG8_BAR; }
    PG8_BAR;
    if constexpr (Epi::AFTER_DRAIN) { E.fused(acc, cur, wr, wc, fr, fq, lds, wid, lane); S.done(cur); }
#undef PG8_SA
#undef PG8_SB
#undef PG8_STAGE
#undef PG8_LDA
#undef PG8_LDB
#undef PG8_MMA
#undef PG8_WAIT_V
#undef PG8_WAIT_L
#undef PG8_BAR
#undef PG8_SCHED
}
}
namespace pg8 {
struct EpiF32 {
    static constexpr bool PERM = false, AFTER_DRAIN = false;
    float* C; int ldc;
    __device__ __forceinline__ void operator()(const f32x4 (&acc)[2][2][4][2], const Unit& u, int wr, int wc, int fr, int fq) const {
        const int row0 = u.pm * BM + wr * 64 + fr, col0 = u.pn * BM + wc * 32 + 4 * fq;
#pragma unroll
        for (int ai = 0; ai < 2; ++ai)
#pragma unroll
            for (int m = 0; m < 4; ++m) { float* rowp = C + (size_t)(row0 + ai * HALF + m * 16) * ldc + col0;
#pragma unroll
                for (int bj = 0; bj < 2; ++bj)
#pragma unroll
                    for (int n = 0; n < 2; ++n) *(f32x4*)(rowp + bj * HALF + n * 16) = acc[ai][bj][m][n]; }
    }
};
}
#ifndef PG8_SP2
#define PG8_SP2 true
#endif
#ifndef PG8_ALIGN
#define PG8_ALIGN true
#endif
#endif
constexpr int BATCH = 4, SEQ = 2048, DM = 2048, DEPTH = 2;
constexpr int MTOK = BATCH * SEQ;
constexpr int DBR = 512;
constexpr int D_IN = 6016, LDP = 6144;
constexpr int CA_R = 0, CA_K = 512, CA_V = 1024, CA_WD = 1536, CA_AD = 1600, A_COLS = 1664;
constexpr int CB_Q = 1664, CB_K = 2176, CB_V = 2304;
constexpr int CC_Z = 2432;
constexpr int CD_U = 2944, CD_V = 3456;
constexpr int CG = 3968;
constexpr float NORM_EPS = 1e-6f, LN_EPS = 1e-5f, GN_EPS = 64e-5f;

typedef unsigned short bf16;
#define HD __host__ __device__ __forceinline__
HD float bf2f(bf16 v) { return __builtin_bit_cast(float, ((unsigned)v) << 16); }
HD bf16 f2bf(float f) { unsigned u = __builtin_bit_cast(unsigned, f); return (bf16)((u + 0x7fffu + ((u >> 16) & 1u)) >> 16); }
HD float silu_f(float g) { return g / (1.f + expf(-g)); }
HD float gelu_f(float x) { return 0.5f * x * (1.f + erff(x * 0.70710678118654752f)); }
HD float sigmoid_f(float x) { return 1.f / (1.f + expf(-x)); }
HD float softplus_f(float x) { return x > 20.f ? x : log1pf(expf(x)); }

struct NP {
    int B, T;
    const bf16* proj;
    bf16* Y;
    float *TW, *R, *W, *K2, *V, *A, *Bv, *YR, *POOLED, *VN;
    const float *mu, *w0, *w_up, *a0, *a_up, *k_k, *k_a, *r_k, *ln_w, *ln_b, *sinks, *pool_w, *pool_scale, *sgu_norm_w, *sgu_w, *sgu_b;
};
HD float pj(const NP& p, int m, int col) { return bf2f(p.proj[(size_t)m * LDP + col]); }
HD float zshift(const NP& p, int m, int t, int col) { const float z = pj(p, m, col); const float zp = t > 0 ? pj(p, m - 1, col) : 0.f; return z + p.mu[col] * (zp - z); }

HD void n_tw(const NP& p, int item) {
    const int m = item >> 7, j = item & 127, t = m % p.T;
    const float z = zshift(p, m, t, CA_WD + j);
    p.TW[item] = j < 64 ? tanhf(z) : z;
}
HD void n_pool_pre(const NP& p, int item) {
    const int m = item >> 9, c = item & 511, g = c >> 7, t = m % p.T, w = 2 << g;
    const int cnt = (t + 1) < w ? (t + 1) : w;
    float s = 0.f;
    for (int q = 0; q < cnt; ++q) s += pj(p, m - q, CC_Z + c);
    p.POOLED[item] = s / (float)cnt - pj(p, m, CC_Z + c);
}
HD void n_sgu_pre(const NP& p, int m) {
    float s = 0.f, ss = 0.f;
    for (int c = 0; c < DBR; ++c) { const float g = gelu_f(pj(p, m, CD_V + c)); s += g; ss += g * g; p.VN[(size_t)m * DBR + c] = g; }
    const float mean = s * (1.f / DBR); float var = ss * (1.f / DBR) - mean * mean; var = var < 0.f ? 0.f : var;
    const float rstd = 1.f / sqrtf(var + LN_EPS);
    for (int c = 0; c < DBR; ++c) { const size_t i = (size_t)m * DBR + c; p.VN[i] = (p.VN[i] - mean) * rstd * p.sgu_norm_w[c]; }
}
HD void n_rwkv_prep(const NP& p, int item) {
    const int m = item >> 9, c = item & 511, t = m % p.T;
    const float r = zshift(p, m, t, CA_R + c), k = zshift(p, m, t, CA_K + c), v = zshift(p, m, t, CA_V + c);
    float wl = p.w0[c], al = p.a0[c];
    const float* tw = p.TW + (size_t)m * 128;
    for (int j = 0; j < 64; ++j) { wl += tw[j] * p.w_up[j * DBR + c]; al += tw[64 + j] * p.a_up[j * DBR + c]; }
    const float w_log = -softplus_f(-wl) - 0.5f;
    const float decay = expf(-expf(w_log));
    const float a = sigmoid_f(al);
    p.R[item] = r; p.W[item] = decay; p.V[item] = v;
    p.K2[item] = k * (1.f + (a - 1.f) * p.k_a[c]);
    p.A[item] = k * p.k_k[c];
    p.Bv[item] = a;
}
HD void n_rwkv_fin(const NP& p, int item) {
    const size_t base = (size_t)item * 64;
    float ss = 0.f;
    for (int j = 0; j < 64; ++j) { const float x = p.A[base + j]; ss += x * x; }
    const float nrm = sqrtf(ss), inv = 1.f / (nrm > 1e-12f ? nrm : 1e-12f);
    for (int j = 0; j < 64; ++j) { const float kk = p.A[base + j] * inv, a = p.Bv[base + j]; p.A[base + j] = -kk; p.Bv[base + j] = kk * a; }
}
HD void n_rwkv_scan(const NP& p, int item) {
    const int bh = item >> 6, i = item & 63, b = bh >> 3, h = bh & 7;
    float S[64];
#pragma unroll
    for (int j = 0; j < 64; ++j) S[j] = 0.f;
    for (int t = 0; t < p.T; ++t) {
        const size_t base = ((size_t)(b * p.T + t)) * DBR + h * 64;
        const float* A = p.A + base; const float* Bv = p.Bv + base; const float* W = p.W + base; const float* K2 = p.K2 + base; const float* R = p.R + base;
        const float v = p.V[base + i];
        float sa = 0.f;
#pragma unroll
        for (int j = 0; j < 64; ++j) sa += S[j] * A[j];
        float y = 0.f;
#pragma unroll
        for (int j = 0; j < 64; ++j) { S[j] = S[j] * W[j] + sa * Bv[j] + v * K2[j]; y += S[j] * R[j]; }
        p.YR[base + i] = y;
    }
}
HD void n_rwkv_post(const NP& p, int item) {
    const int m = item >> 3, h = item & 7; const size_t base = (size_t)m * DBR + h * 64;
    float s = 0.f, rk = 0.f;
    for (int c = 0; c < 64; ++c) { s += p.YR[base + c]; rk += p.R[base + c] * p.K2[base + c] * p.r_k[h * 64 + c]; }
    const float mean = s * (1.f / 64.f); float q = 0.f;
    for (int c = 0; c < 64; ++c) { const float d = p.YR[base + c] - mean; q += d * d; }
    const float rstd = 1.f / sqrtf(q * (1.f / 64.f) + GN_EPS);
    for (int c = 0; c < 64; ++c) {
        const int ch = h * 64 + c;
        const float o = (p.YR[base + c] - mean) * rstd * p.ln_w[ch] + p.ln_b[ch] + rk * p.V[base + c];
        p.Y[(size_t)m * DM + ch] = f2bf(o * silu_f(pj(p, m, CG + ch)));
    }
}
HD void n_swa(const NP& p, int item) {
    const int m = item >> 3, h = item & 7, kvh = h >> 2, t = m % p.T;
    const float slope = exp2f(-(float)(h + 1));
    float q[64];
#pragma unroll
    for (int d = 0; d < 64; ++d) q[d] = pj(p, m, CB_Q + h * 64 + d) * 0.125f;
    const int nk = t < 127 ? t + 1 : 128;
    float mx = p.sinks[h];
    for (int dist = 0; dist < nk; ++dist) {
        const bf16* kr = p.proj + (size_t)(m - dist) * LDP + CB_K + kvh * 64;
        float s = 0.f;
#pragma unroll
        for (int d = 0; d < 64; ++d) s += q[d] * bf2f(kr[d]);
        s -= slope * (float)dist;
        mx = s > mx ? s : mx;
    }
    float o[64];
#pragma unroll
    for (int d = 0; d < 64; ++d) o[d] = 0.f;
    float den = expf(p.sinks[h] - mx);
    for (int dist = 0; dist < nk; ++dist) {
        const bf16* kr = p.proj + (size_t)(m - dist) * LDP + CB_K + kvh * 64;
        const bf16* vr = p.proj + (size_t)(m - dist) * LDP + CB_V + kvh * 64;
        float s = 0.f;
#pragma unroll
        for (int d = 0; d < 64; ++d) s += q[d] * bf2f(kr[d]);
        s -= slope * (float)dist;
        const float pr = expf(s - mx); den += pr;
#pragma unroll
        for (int d = 0; d < 64; ++d) o[d] += pr * bf2f(vr[d]);
    }
    const float inv = 1.f / den;
#pragma unroll
    for (int d = 0; d < 64; ++d) { const int ch = DBR + h * 64 + d; p.Y[(size_t)m * DM + ch] = f2bf(o[d] * inv * silu_f(pj(p, m, CG + ch))); }
}
HD void n_pool_out(const NP& p, int item) {
    const int m = item >> 9, c = item & 511, g = c >> 7, d = c & 127;
    const float* pl = p.POOLED + (size_t)m * DBR + g * 128; const float* w = p.pool_w + (size_t)g * 128 * 128 + d;
    float y = 0.f;
    for (int cc = 0; cc < 128; ++cc) y += pl[cc] * w[cc * 128];
    y *= p.pool_scale[c];
    const int ch = 2 * DBR + c;
    p.Y[(size_t)m * DM + ch] = f2bf(y * silu_f(pj(p, m, CG + ch)));
}
HD void n_sgu_out(const NP& p, int item) {
    const int m = item >> 9, c = item & 511, g = c >> 7, t = m % p.T, i = t & 127, m0 = m - i;
    const float* wrow = p.sgu_w + ((size_t)g * 128 + i) * 128;
    float s = p.sgu_b[g * 128 + i];
    for (int j = 0; j <= i; ++j) s += wrow[j] * p.VN[(size_t)(m0 + j) * DBR + c];
    const float u = gelu_f(pj(p, m, CD_U + c));
    const int ch = 3 * DBR + c;
    p.Y[(size_t)m * DM + ch] = f2bf(u * s * silu_f(pj(p, m, CG + ch)));
}
#ifndef HOST_TEST
constexpr int NWAVES = 8;
#ifndef MK_ONE_LAUNCH
#define MK_ONE_LAUNCH 0
#endif
constexpr int NPL = 8;
constexpr int NPHASES = 1 + DEPTH * NPL;

constexpr size_t MiB = 1u << 20;
constexpr size_t WS_CTL = 0, CTL_ZERO_BYTES = 1 * MiB;
constexpr size_t WS_WIN = 1 * MiB;
constexpr size_t WS_WOUT = WS_WIN + 48 * MiB;
constexpr size_t WS_XN = WS_WOUT + 16 * MiB;
constexpr size_t WS_PROJ = WS_XN + 32 * MiB;
constexpr size_t WS_O = WS_PROJ;
constexpr size_t WS_Y = WS_PROJ + 96 * MiB;
constexpr size_t WS_RW = WS_Y + 32 * MiB;
constexpr size_t WS_POOLED = WS_RW + 112 * MiB;
constexpr size_t WS_VN = WS_POOLED + 16 * MiB;
constexpr size_t WS_TW = WS_VN + 16 * MiB;
constexpr size_t WS_END = WS_TW + 4 * MiB;
constexpr int CW_TMO = 0, CW_CODE = 1, CW_BAR = 4096;

constexpr int RING_OFF = 0, RING_BYTES = 131072;
constexpr int LDSCTL_OFF = RING_BYTES, MISC_OFF = LDSCTL_OFF + 320;
constexpr int LDS_BYTES = 147456;

#define GAS __attribute__((address_space(1)))
#define LAS __attribute__((address_space(3)))
typedef unsigned v4u __attribute__((ext_vector_type(4)));
typedef float f32x4 __attribute__((ext_vector_type(4)));
typedef GAS unsigned gu32;
#define RLX_AGENT __ATOMIC_RELAXED, __HIP_MEMORY_SCOPE_AGENT
#define LDS_WAIT() asm volatile("s_waitcnt lgkmcnt(0)" ::: "memory")
#define VM_WAIT() asm volatile("s_waitcnt vmcnt(0)" ::: "memory")
__device__ __forceinline__ unsigned pk2(float lo, float hi) { return (unsigned)f2bf(lo) | ((unsigned)f2bf(hi) << 16); }
#define XB_TMO      128
#define XB_XCNT(j)  (256  + 64 * (j))
#define XB_XSUB(j)  (1280 + 64 * (j))
#define XB_XGEN(j)  (2304 + 64 * (j))
#define XB_TOP      3328
#define XB_TOPGEN   3392
#define XCD_BAR_WORDS 3456
#define XB_SPIN_CAP (1u << 18)

__device__ __forceinline__ unsigned xb_ld(unsigned* p)              { return __hip_atomic_load(p, __ATOMIC_RELAXED, __HIP_MEMORY_SCOPE_AGENT); }
__device__ __forceinline__ unsigned xb_add(unsigned* p, unsigned v) { return __hip_atomic_fetch_add(p, v, __ATOMIC_RELAXED, __HIP_MEMORY_SCOPE_AGENT); }
__device__ __forceinline__ unsigned xb_xcc_id() { return (unsigned)__builtin_amdgcn_s_getreg((3 << 11) | 20) & 0xFu; }
#define XB_SPIN(cond, bar) do { unsigned _sp = 0; while (cond) { __builtin_amdgcn_s_sleep(1); \
    if ((++_sp & 255u) == 0u) { if (xb_ld(&(bar)[XB_TMO])) break; if (_sp > XB_SPIN_CAP) { atomicAdd(&(bar)[XB_TMO], 1u); break; } } } } while (0)

struct XcdBarrier {
    unsigned* bar; unsigned x;
    volatile LAS unsigned* st;
};

__device__ __forceinline__ XcdBarrier xcd_barrier_post(unsigned* bar, volatile LAS unsigned* st) {
    XcdBarrier b; b.bar = bar; b.x = xb_xcc_id(); b.st = st;
    if (threadIdx.x == 0) (void)xb_add(&bar[XB_XCNT(b.x)], 1u);
    return b;
}
__device__ __forceinline__ void xcd_barrier_complete(unsigned* bar, unsigned x, unsigned& nloc, unsigned& nx) {
    const unsigned G = gridDim.x * gridDim.y * gridDim.z;
    unsigned sum, cnt, mine, sp = 0u;
    for (;;) {
        sum = 0u; cnt = 0u; mine = 0u;
#pragma unroll
        for (unsigned j = 0; j < 16; ++j) { const unsigned c = xb_ld(&bar[XB_XCNT(j)]); sum += c; cnt += (c > 0u) ? 1u : 0u; mine = (j == x) ? c : mine; }
        if (sum == G) break;
        __builtin_amdgcn_s_sleep(1);
        if ((++sp & 255u) == 0u) { if (xb_ld(&bar[XB_TMO])) break; if (sp > XB_SPIN_CAP) { atomicAdd(&bar[XB_TMO], 1u); break; } }
    }
    nloc = mine > 0u ? mine : 1u; nx = cnt > 0u ? cnt : 1u;
}

__device__ __forceinline__ void xcd_barrier(const XcdBarrier& b) {
    asm volatile("s_waitcnt vmcnt(0)" ::: "memory");
    __syncthreads();
    if (threadIdx.x == 0) {
        unsigned* bar = b.bar;
        __builtin_amdgcn_s_waitcnt(0);
        unsigned nloc = b.st[0], nx = b.st[1];
        if (nloc == 0u) { xcd_barrier_complete(bar, b.x, nloc, nx); b.st[0] = nloc; b.st[1] = nx; }
        const unsigned old = xb_add(&bar[XB_XSUB(b.x)], 1u);
        const unsigned gen = old / nloc;
        if (old + 1u == (gen + 1u) * nloc) {
            __builtin_amdgcn_fence(__ATOMIC_RELEASE, "agent");
            asm volatile("s_waitcnt vmcnt(0)" ::: "memory");
            const unsigned og = xb_add(&bar[XB_TOP], 1u);
            const unsigned tg = og / nx;
            if (og + 1u == (tg + 1u) * nx) xb_add(&bar[XB_TOPGEN], 1u);
            else XB_SPIN(xb_ld(&bar[XB_TOPGEN]) == tg, bar);
            __builtin_amdgcn_fence(__ATOMIC_ACQUIRE, "agent");
            xb_add(&bar[XB_XGEN(b.x)], 1u);
            asm volatile("s_waitcnt vmcnt(0)" ::: "memory");
        } else {
            XB_SPIN(xb_ld(&bar[XB_XGEN(b.x)]) == gen, bar);
            __builtin_amdgcn_fence(__ATOMIC_ACQUIRE, "agent");
            asm volatile("s_waitcnt vmcnt(0)" ::: "memory");
        }
    }
    __syncthreads();
}
__device__ __forceinline__ float wave_sum(float v) {
#pragma unroll
    for (int o = 1; o < 64; o <<= 1) v += __shfl_xor(v, o);
    return v;
}
__device__ __forceinline__ void p0_transpose_item(const float* W, int K, int N, bf16* WT, LAS float* scr, int item, int lane) {
    const int nblk = N / 32, kb = item / nblk, nb = item % nblk, k0 = 64 * kb, n0 = 32 * nb;
#pragma unroll 8
    for (int i = 0; i < 32; ++i) { const int kk = 2 * i + (lane >> 5); scr[kk * 33 + (lane & 31)] = W[(size_t)(k0 + kk) * N + n0 + (lane & 31)]; }
    LDS_WAIT(); asm volatile("" ::: "memory");
    const int c = lane & 7;
#pragma unroll
    for (int j = 0; j < 4; ++j) { const int n = (lane >> 3) + 8 * j; const LAS float* s = scr + (8 * c) * 33 + n;
        v4u o; o.x = pk2(s[0 * 33], s[1 * 33]); o.y = pk2(s[2 * 33], s[3 * 33]); o.z = pk2(s[4 * 33], s[5 * 33]); o.w = pk2(s[6 * 33], s[7 * 33]);
        *(GAS v4u*)(WT + (size_t)(n0 + n) * K + k0 + 8 * c) = o; }
    LDS_WAIT(); asm volatile("" ::: "memory");
}
__device__ __forceinline__ void rms_row_to_bf16(const float* xrow, const float* w, bf16* orow, int lane) {
    const GAS f32x4* xr = (const GAS f32x4*)xrow + lane; const GAS f32x4* wr = (const GAS f32x4*)w + lane;
    f32x4 v[8]; float s = 0.f;
#pragma unroll
    for (int j = 0; j < 8; ++j) { v[j] = xr[64 * j]; s += (v[j].x * v[j].x + v[j].y * v[j].y) + (v[j].z * v[j].z + v[j].w * v[j].w); }
    const float rs = 1.f / sqrtf(wave_sum(s) * (1.f / DM) + NORM_EPS);
    GAS unsigned long long* o8 = (GAS unsigned long long*)orow + lane;
#pragma unroll
    for (int j = 0; j < 8; ++j) { const f32x4 ww = wr[64 * j];
        o8[64 * j] = (unsigned long long)pk2(v[j].x * rs * ww.x, v[j].y * rs * ww.y) | ((unsigned long long)pk2(v[j].z * rs * ww.z, v[j].w * rs * ww.w) << 32); }
}
__device__ __forceinline__ void post_row(const float* orow, const float* xin, const float* post_w, float* xout, const float* pre_w_next, bf16* xn, int lane) {
    const GAS f32x4* op = (const GAS f32x4*)orow + lane; const GAS f32x4* xp = (const GAS f32x4*)xin + lane; const GAS f32x4* pw = (const GAS f32x4*)post_w + lane;
    f32x4 v[8]; float s = 0.f;
#pragma unroll
    for (int j = 0; j < 8; ++j) { v[j] = op[64 * j]; s += (v[j].x * v[j].x + v[j].y * v[j].y) + (v[j].z * v[j].z + v[j].w * v[j].w); }
    const float rs = 1.f / sqrtf(wave_sum(s) * (1.f / DM) + NORM_EPS);
    float s2 = 0.f;
    GAS f32x4* xo = (GAS f32x4*)xout + lane;
#pragma unroll
    for (int j = 0; j < 8; ++j) { const f32x4 xx = xp[64 * j], ww = pw[64 * j]; v[j] = xx + v[j] * rs * ww; xo[64 * j] = v[j];
        s2 += (v[j].x * v[j].x + v[j].y * v[j].y) + (v[j].z * v[j].z + v[j].w * v[j].w); }
    if (pre_w_next) {
        const float rs2 = 1.f / sqrtf(wave_sum(s2) * (1.f / DM) + NORM_EPS);
        const GAS f32x4* wr = (const GAS f32x4*)pre_w_next + lane; GAS unsigned long long* o8 = (GAS unsigned long long*)xn + lane;
#pragma unroll
        for (int j = 0; j < 8; ++j) { const f32x4 ww = wr[64 * j];
            o8[64 * j] = (unsigned long long)pk2(v[j].x * rs2 * ww.x, v[j].y * rs2 * ww.y) | ((unsigned long long)pk2(v[j].z * rs2 * ww.z, v[j].w * rs2 * ww.w) << 32); }
    }
}

#ifndef GM
#define GM 3
#endif
#ifndef PHM
#define PHM 1023
#endif
struct Args { const float* in[21]; float* out; unsigned char* ws; int ph_lo, ph_hi; };
__device__ __forceinline__ int opaque_tid() { int t = threadIdx.x; asm volatile("" : "+v"(t)); return t; }
#define TID (opaque_tid())
#define LANE (TID & 63)
#define WAVE (__builtin_amdgcn_readfirstlane(TID >> 6))
#define GRIDN ((int)gridDim.x)
#define VCU ((GRIDN % 8 == 0) ? ((int)blockIdx.x % 8) * (GRIDN / 8) + (int)blockIdx.x / 8 : (int)blockIdx.x)
#define GTID (VCU * (NWAVES * 64) + TID)
#define GTN (GRIDN * NWAVES * 64)
#define GWV (VCU * NWAVES + WAVE)
#define NGWV (GRIDN * NWAVES)
__device__ __forceinline__ NP make_np(const Args& args, int l) {
    unsigned char* ws = args.ws; NP p;
    p.B = BATCH; p.T = SEQ; p.proj = (const bf16*)(ws + WS_PROJ); p.Y = (bf16*)(ws + WS_Y);
    { float* rw = (float*)(ws + WS_RW); const size_t st = (size_t)MTOK * DBR;
      p.R = rw; p.W = rw + st; p.K2 = rw + 2 * st; p.V = rw + 3 * st; p.A = rw + 4 * st; p.Bv = rw + 5 * st; p.YR = rw + 6 * st; }
    p.POOLED = (float*)(ws + WS_POOLED); p.VN = (float*)(ws + WS_VN); p.TW = (float*)(ws + WS_TW);
    p.mu = args.in[4] + l * A_COLS; p.w0 = args.in[5] + l * DBR; p.w_up = args.in[6] + l * 64 * DBR; p.a0 = args.in[7] + l * DBR; p.a_up = args.in[8] + l * 64 * DBR;
    p.k_k = args.in[9] + l * DBR; p.k_a = args.in[10] + l * DBR; p.r_k = args.in[11] + l * DBR; p.ln_w = args.in[12] + l * DBR; p.ln_b = args.in[13] + l * DBR;
    p.sinks = args.in[14] + l * 8; p.pool_w = args.in[15] + l * 4 * 128 * 128; p.pool_scale = args.in[16] + l * DBR; p.sgu_norm_w = args.in[17] + l * DBR;
    p.sgu_w = args.in[18] + l * 4 * 128 * 128; p.sgu_b = args.in[19] + l * 4 * 128;
    return p;
}
__global__ void __launch_bounds__(NWAVES * 64, 2) skel_fwd(Args args) {
    extern __shared__ __attribute__((aligned(16))) unsigned char lds[];
    LAS unsigned char* ldsp = (LAS unsigned char*)lds;
    for (int u = TID; u < (LDS_BYTES - LDSCTL_OFF) / 4; u += NWAVES * 64) ((LAS unsigned*)(ldsp + LDSCTL_OFF))[u] = 0u;
    __syncthreads();
#if MK_ONE_LAUNCH
    XcdBarrier bar = xcd_barrier_post((unsigned*)(args.ws + WS_CTL) + CW_BAR, (volatile LAS unsigned*)(ldsp + MISC_OFF) + 8);
#define GRID_BAR() xcd_barrier(bar)
#else
#define GRID_BAR() do { } while (0)
#endif
#define IN(k) (args.ph_lo <= (k) && (k) < args.ph_hi)
#define SEAM(k) do { if (IN((k) + 1)) GRID_BAR(); } while (0)

    if (IN(0)) {
        bf16* Win_t = (bf16*)(args.ws + WS_WIN); bf16* Wout_t = (bf16*)(args.ws + WS_WOUT); bf16* XN = (bf16*)(args.ws + WS_XN);
        const int lane = LANE, gw = GWV, NGW = NGWV;
        LAS float* scr = (LAS float*)(ldsp + RING_OFF + WAVE * 16384);
        constexpr int I_IN = (DM / 64) * (D_IN / 32), I_OUT = (DM / 64) * (DM / 32), NITEMS = DEPTH * (I_IN + I_OUT);
        for (int it = gw; it < NITEMS; it += NGW) {
            int r = it; const int l = r / (I_IN + I_OUT); r -= l * (I_IN + I_OUT);
            if (r < I_IN) p0_transpose_item(args.in[3] + (size_t)l * DM * D_IN, DM, D_IN, Win_t + (size_t)l * LDP * DM, scr, r, lane);
            else p0_transpose_item(args.in[20] + (size_t)l * DM * DM, DM, DM, Wout_t + (size_t)l * DM * DM, scr, r - I_IN, lane);
        }
        constexpr int PADV = (LDP - D_IN) * DM / 8;
        for (int i = GTID; i < DEPTH * PADV; i += GTN) { const int l = i / PADV, r = i % PADV; ((GAS v4u*)(Win_t + (size_t)l * LDP * DM + (size_t)D_IN * DM))[r] = (v4u){0u, 0u, 0u, 0u}; }
        for (int m = gw; m < MTOK; m += NGW) rms_row_to_bf16(args.in[0] + (size_t)m * DM, args.in[1], XN + (size_t)m * DM, lane);
        SEAM(0);
    }
    for (int l = 0; l < DEPTH; ++l) {
        const int pb = 1 + l * NPL;
        if ((GM & 1) && IN(pb + 0)) {
            pg8::Gemm g{(const bf16*)(args.ws + WS_XN), (const bf16*)(args.ws + WS_WIN) + (size_t)l * LDP * DM, MTOK, LDP, DM}; pg8::StaticOrder S; S.init(MTOK, LDP, GRIDN, (int)blockIdx.x);
            pg8::EpiBf16<0> E{(bf16*)(args.ws + WS_PROJ), LDP, nullptr, 0, 0, 1.f};
            pg8::gemm_phase<pg8::EpiBf16<0>, pg8::StaticOrder, PG8_ALIGN, PG8_SP2>(ldsp + RING_OFF, g, S, E);
            SEAM(pb + 0);
        }
        if (IN(pb + 1)) {
            const NP p = make_np(args, l); const int gtid = GTID, GT = GTN;
            if (PHM & 1) for (int i = gtid; i < MTOK * 128; i += GT) n_tw(p, i);
            if (PHM & 2) for (int i = gtid; i < MTOK * DBR; i += GT) n_pool_pre(p, i);
            if (PHM & 4) for (int i = gtid; i < MTOK; i += GT) n_sgu_pre(p, i);
            SEAM(pb + 1);
        }
        if (IN(pb + 2)) { const NP p = make_np(args, l); const int gtid = GTID, GT = GTN; if (PHM & 8) for (int i = gtid; i < MTOK * DBR; i += GT) n_rwkv_prep(p, i); SEAM(pb + 2); }
        if (IN(pb + 3)) { const NP p = make_np(args, l); const int gtid = GTID, GT = GTN; if (PHM & 16) for (int i = gtid; i < MTOK * 8; i += GT) n_rwkv_fin(p, i); SEAM(pb + 3); }
        if (IN(pb + 4)) {
            const NP p = make_np(args, l); const int gtid = GTID, GT = GTN;
            if (PHM & 32) for (int i = gtid; i < BATCH * 8 * 64; i += GT) n_rwkv_scan(p, i);
            if (PHM & 64) for (int i = gtid; i < MTOK * 8; i += GT) n_swa(p, i);
            if (PHM & 128) for (int i = gtid; i < MTOK * DBR; i += GT) n_pool_out(p, i);
            if (PHM & 256) for (int i = gtid; i < MTOK * DBR; i += GT) n_sgu_out(p, i);
            SEAM(pb + 4);
        }
        if (IN(pb + 5)) { const NP p = make_np(args, l); const int gtid = GTID, GT = GTN; if (PHM & 512) for (int i = gtid; i < MTOK * 8; i += GT) n_rwkv_post(p, i); SEAM(pb + 5); }
        if ((GM & 2) && IN(pb + 6)) {
            pg8::Gemm g{(const bf16*)(args.ws + WS_Y), (const bf16*)(args.ws + WS_WOUT) + (size_t)l * DM * DM, MTOK, DM, DM}; pg8::StaticOrder S; S.init(MTOK, DM, GRIDN, (int)blockIdx.x);
            pg8::EpiF32 E{(float*)(args.ws + WS_O), DM};
            pg8::gemm_phase<pg8::EpiF32, pg8::StaticOrder, PG8_ALIGN, PG8_SP2>(ldsp + RING_OFF, g, S, E);
            SEAM(pb + 6);
        }
        if (IN(pb + 7)) {
            const float* xin = (l == 0) ? args.in[0] : (const float*)args.out;
            const float* pre_next = (l + 1 < DEPTH) ? args.in[1] + (size_t)(l + 1) * DM : nullptr;
            const float* OB = (const float*)(args.ws + WS_O); bf16* XN = (bf16*)(args.ws + WS_XN);
            const int lane = LANE, NGW = NGWV;
            for (int m = GWV; m < MTOK; m += NGW)
                post_row(OB + (size_t)m * DM, xin + (size_t)m * DM, args.in[2] + (size_t)l * DM, args.out + (size_t)m * DM, pre_next, XN + (size_t)m * DM, lane);
            SEAM(pb + 7);
        }
    }
#undef IN
#undef SEAM
}

extern "C" void kernel_launch(void* const* d_in, const int* in_sizes, int n_in, void* d_out, int out_size, void* d_ws, size_t ws_size, hipStream_t stream) {
    static int grid = 0;
    if (grid == 0) {
        if (n_in != 21 || in_sizes[0] != MTOK * DM || out_size != MTOK * DM || ws_size < WS_END) {
            fprintf(stderr, "kernel_launch: shape/workspace mismatch: n_in %d in0 %d out %d ws %zu (need %zu); nothing launched\n", n_in, n_in > 0 ? in_sizes[0] : -1, out_size, ws_size, (size_t)WS_END); grid = -1; return; }
        int dev = 0, cus = 0;
        if (hipGetDevice(&dev) != hipSuccess || hipDeviceGetAttribute(&cus, hipDeviceAttributeMultiprocessorCount, dev) != hipSuccess) { grid = -1; return; }
        if (hipFuncSetAttribute((const void*)skel_fwd, hipFuncAttributeMaxDynamicSharedMemorySize, LDS_BYTES) != hipSuccess) { fprintf(stderr, "kernel_launch: hipFuncSetAttribute failed\n"); grid = -1; return; }
        (void)hipGetLastError();
        grid = cus;
    }
    if (grid < 0) return;
    if (hipMemsetAsync((char*)d_ws + WS_CTL, 0, CTL_ZERO_BYTES, stream) != hipSuccess) return;
    Args a{};
    for (int i = 0; i < 21; ++i) a.in[i] = (const float*)d_in[i];
    a.out = (float*)d_out; a.ws = (unsigned char*)d_ws;
#if MK_ONE_LAUNCH
    a.ph_lo = 0; a.ph_hi = NPHASES;
    hipLaunchKernelGGL(skel_fwd, dim3(grid), dim3(NWAVES * 64), LDS_BYTES, stream, a);
#else
    for (int ph = 0; ph < NPHASES; ++ph) { a.ph_lo = ph; a.ph_hi = ph + 1; hipLaunchKernelGGL(skel_fwd, dim3(grid), dim3(NWAVES * 64), LDS_BYTES, stream, a); }
#endif
}
#endif
```

```cpp
#include <hip/hip_runtime.h>
#include <cstdio>
#include <cstdint>
#include <cmath>
#ifndef HOST_TEST
namespace pg8 {
#define PG8_LAS __attribute__((address_space(3)))
typedef unsigned short bf16_t;
typedef short bf16x8 __attribute__((ext_vector_type(8)));
typedef float f32x4 __attribute__((ext_vector_type(4)));
typedef unsigned u32x4 __attribute__((ext_vector_type(4)));
constexpr int BM = 256, BK = 64, HALF = 128, HTB = HALF * BK * 2  , STAGE_BYTES = 8 * HTB, NXCD = 8, WGM = 8;

__host__ __device__ __forceinline__ int lds_byte(int r, int c) { const int st = (r >> 4) * 2 + (c >> 5), rr = r & 15, cc = c & 31, ob = rr * 64 + cc * 2; return st * 1024 + (ob ^ (((ob >> 9) & 1) << 5)); }
__host__ __device__ __forceinline__ void stage_rc(int b, int& R, int& C) { const int st = b / 1024, sb = b % 1024, swz = sb ^ (((sb >> 9) & 1) << 5); R = (st >> 1) * 16 + swz / 64; C = (st & 1) * 32 + (swz % 64) / 2; }
__host__ __device__ __forceinline__ int perm32(int rho) { const int n = rho >> 4, i = rho & 15; return 8 * (i >> 2) + 4 * n + (i & 3); }

struct Unit { int pm, pn; };
struct Gemm { const bf16_t* A; const bf16_t* Bt; int M, N, K; };

struct StaticOrder {
    int nM, nN, nwg, G, c;
    __host__ __device__ void init(int M, int N, int G_, int c_) { nM = M / BM; nN = N / BM; nwg = nM * nN; G = G_; c = c_; }
    __host__ __device__ bool next(int i, Unit& u) const {
        const long L = (long)i * G + c; if (L >= nwg) return false;
        int wgid = (int)L; { const int q = nwg / NXCD, r = nwg % NXCD, xcd = wgid % NXCD, off = wgid / NXCD; wgid = (xcd < r ? xcd * (q + 1) : r * (q + 1) + (xcd - r) * q) + off; }
        const int nig = WGM * nN, gid = wgid / nig, fm = gid * WGM, gsz = (nM - fm) < WGM ? (nM - fm) : WGM;
        u.pm = fm + ((wgid % nig) % gsz); u.pn = (wgid % nig) / gsz; return true;
    }
    __device__ __forceinline__ void a_ready(const Unit&) const {}
    __device__ __forceinline__ void done(const Unit&) const {}
};

__device__ __forceinline__ unsigned cvt_pk_bf16(float lo, float hi) { unsigned r; asm volatile("v_cvt_pk_bf16_f32 %0, %1, %2" : "=v"(r) : "v"(lo), "v"(hi)); return r; }
typedef float f32x2 __attribute__((ext_vector_type(2)));
__device__ __forceinline__ f32x2 gelu_pk(f32x2 v) {
    const f32x2 av = __builtin_elementwise_abs(v), d = av * 0.2316418882f + 1.0f;
    f32x2 t; t.x = __builtin_amdgcn_rcpf(d.x); t.y = __builtin_amdgcn_rcpf(d.y);
    f32x2 q = t * 0.5307027145f + (-0.7265760135f); q = q * t + 0.7107068705f; q = q * t + (-0.142248368f); q = q * t + 0.127414796f; q = q * t;
    const f32x2 s = (v * v) * (-0.72134752044f);
    f32x2 e; e.x = __builtin_amdgcn_exp2f(s.x); e.y = __builtin_amdgcn_exp2f(s.y);
    const f32x2 m = v * (q * e), r = v - m;
    f32x2 o; o.x = v.x < 0.f ? m.x : r.x; o.y = v.y < 0.f ? m.y : r.y; return o;
}

template <int ACT  > struct EpiBf16 {
    static constexpr bool PERM = true, AFTER_DRAIN = false; static_assert(ACT == 0 || ACT == 1, "EpiBf16: ACT is 0 (none) or 1 (gelu_pk)");
    bf16_t* O; int ldc; const float* bias; int split_cols; size_t split_stride; float scale0;
    __device__ __forceinline__ void operator()(const f32x4 (&acc)[2][2][4][2], const Unit& u, int wr, int wc, int fr, int fq) const {
        const int row0 = u.pm * BM + wr * 64 + fr; int colt = u.pn * BM; bf16_t* base = O;
        float sc = 1.f; if (split_cols) { const int t = colt / split_cols; base += (size_t)t * split_stride; colt -= t * split_cols; if (t == 0) sc = scale0; }
        const int col0 = colt + wc * 32 + 8 * fq, bcol0 = u.pn * BM + wc * 32 + 8 * fq;
        f32x4 bv[2][2];
#pragma unroll
        for (int bj = 0; bj < 2; ++bj)
#pragma unroll
            for (int n = 0; n < 2; ++n) bv[bj][n] = bias ? *(const f32x4*)(bias + bcol0 + bj * HALF + 4 * n) : (f32x4){0.f, 0.f, 0.f, 0.f};
#pragma unroll
        for (int ai = 0; ai < 2; ++ai)
#pragma unroll
            for (int m = 0; m < 4; ++m) { bf16_t* rowp = base + (size_t)(row0 + ai * HALF + m * 16) * ldc + col0;
#pragma unroll
                for (int bj = 0; bj < 2; ++bj) { f32x4 v0 = acc[ai][bj][m][0] + bv[bj][0], v1 = acc[ai][bj][m][1] + bv[bj][1];
                    if (ACT == 1) { f32x2 a = gelu_pk((f32x2){v0[0], v0[1]}), b = gelu_pk((f32x2){v0[2], v0[3]}), c = gelu_pk((f32x2){v1[0], v1[1]}), d = gelu_pk((f32x2){v1[2], v1[3]});
                        v0 = (f32x4){a.x, a.y, b.x, b.y}; v1 = (f32x4){c.x, c.y, d.x, d.y}; }
                    v0 = v0 * sc; v1 = v1 * sc; u32x4 w; w.x = cvt_pk_bf16(v0[0], v0[1]); w.y = cvt_pk_bf16(v0[2], v0[3]); w.z = cvt_pk_bf16(v1[0], v1[1]); w.w = cvt_pk_bf16(v1[2], v1[3]);
                    *(u32x4*)(rowp + bj * HALF) = w; } }
    }
};

struct PanelStats {
    unsigned* xbuf;
    unsigned* cnt;
    unsigned* tmo;
    int ntn; float eps;
    unsigned code;
    __device__ __forceinline__ bool run(const f32x4 (&v)[2][2][4][2], const Unit& u, int wr, int wc, int fr, int fq, PG8_LAS unsigned char* lds, int wid, int lane) const {
        typedef float f32x2v __attribute__((ext_vector_type(2)));
        PG8_LAS f32x2v* P = (PG8_LAS f32x2v*)lds;
        PG8_LAS f32x2v* S = (PG8_LAS f32x2v*)(lds + 8192);
        PG8_LAS unsigned* flag = (PG8_LAS unsigned*)(lds + 8192 + 2048);
#pragma unroll
        for (int ai = 0; ai < 2; ++ai)
#pragma unroll
            for (int m = 0; m < 4; ++m) {
                float s = 0.f;
#pragma unroll
                for (int bj = 0; bj < 2; ++bj)
#pragma unroll
                    for (int n = 0; n < 2; ++n) { const f32x4 x = v[ai][bj][m][n]; s += (x[0] + x[1]) + (x[2] + x[3]); }
                s += __shfl_xor(s, 16); s += __shfl_xor(s, 32);
                const float mw = s * (1.0f / 64.0f); float q = 0.f;
#pragma unroll
                for (int bj = 0; bj < 2; ++bj)
#pragma unroll
                    for (int n = 0; n < 2; ++n) { const f32x4 d = v[ai][bj][m][n] - mw; q += (d[0] * d[0] + d[1] * d[1]) + (d[2] * d[2] + d[3] * d[3]); }
                q += __shfl_xor(q, 16); q += __shfl_xor(q, 32);
                if (fq == 0) P[(ai * HALF + wr * 64 + m * 16 + fr) * 4 + wc] = (f32x2v){mw, q};
            }
        asm volatile("s_waitcnt lgkmcnt(0)" ::: "memory"); __builtin_amdgcn_s_barrier(); asm volatile("" ::: "memory");
#if defined(BROKEN_EXCHANGE_NO_WAIT)
#warning BROKEN CONTROL BUILD: the row-statistics exchange does not wait; results are wrong by design
        if (blockIdx.x >= 64) { const long long t0_ = clock64(); while (clock64() - t0_ < 60000) __builtin_amdgcn_s_sleep(8); }
#endif
        const int row = wid * 32 + (lane & 31);
        if (lane < 32) {
            const f32x2v a = P[row * 4 + 0], b = P[row * 4 + 1], c = P[row * 4 + 2], d = P[row * 4 + 3];
            const float mt = (a.x + b.x + c.x + d.x) * 0.25f;
            const float da = a.x - mt, db = b.x - mt, dc = c.x - mt, dd = d.x - mt;
            const float m2 = (a.y + b.y) + (c.y + d.y) + 64.0f * ((da * da + db * db) + (dc * dc + dd * dd));
            unsigned long long* slot = (unsigned long long*)xbuf + ((size_t)(u.pm * BM + row) * 4 + u.pn);
            __hip_atomic_store(slot, ((unsigned long long)__float_as_uint(m2) << 32) | __float_as_uint(mt), __ATOMIC_RELAXED, __HIP_MEMORY_SCOPE_AGENT);
        }
        asm volatile("s_waitcnt vmcnt(0)" ::: "memory");
        if (lane == 0) __hip_atomic_fetch_add(cnt + 64 * u.pm, 1u, __ATOMIC_RELAXED, __HIP_MEMORY_SCOPE_AGENT);
        if (wid == 0) {
            bool dead = false; const unsigned long long t0 = __builtin_amdgcn_s_memrealtime(); const unsigned want = 8u * (unsigned)ntn;
            for (;;) {
#if defined(BROKEN_EXCHANGE_NO_WAIT)
                break;
#endif
                if ((unsigned)__builtin_amdgcn_readfirstlane(__hip_atomic_load(cnt + 64 * u.pm, __ATOMIC_RELAXED, __HIP_MEMORY_SCOPE_AGENT)) >= want) break;
                if (__builtin_amdgcn_s_memrealtime() - t0 > 2000000ull) {
                    if (lane == 0) { unsigned expect = 0u; __hip_atomic_compare_exchange_strong(tmo + 1, &expect, code | (unsigned)(u.pm & 0xff), __ATOMIC_RELAXED, __ATOMIC_RELAXED, __HIP_MEMORY_SCOPE_AGENT);
                                     __hip_atomic_store(tmo, 1u, __ATOMIC_RELAXED, __HIP_MEMORY_SCOPE_AGENT); }
                    dead = true; break; }
                __builtin_amdgcn_s_sleep(2);
            }
            __builtin_amdgcn_fence(__ATOMIC_ACQUIRE, "agent");
            if (lane == 0) flag[0] = dead ? 1u : 0u;
        }
        asm volatile("s_waitcnt vmcnt(0) lgkmcnt(0)" ::: "memory"); __builtin_amdgcn_s_barrier(); asm volatile("" ::: "memory");
        const bool bad = flag[0] != 0u;
        if (lane < 32) {
            const unsigned long long* slot = (const unsigned long long*)xbuf + (size_t)(u.pm * BM + row) * 4; float mt[4], m2[4]; float ms = 0.f;
#pragma unroll
            for (int t = 0; t < 4; ++t) { if (t < ntn) { const unsigned long long w = __hip_atomic_load(slot + t, __ATOMIC_RELAXED, __HIP_MEMORY_SCOPE_AGENT); mt[t] = __uint_as_float((unsigned)w); m2[t] = __uint_as_float((unsigned)(w >> 32)); } else { mt[t] = 0.f; m2[t] = 0.f; } ms += mt[t]; }
            const float mean = ms / (float)ntn; float q = 0.f;
#pragma unroll
            for (int t = 0; t < 4; ++t) if (t < ntn) { const float dm = mt[t] - mean; q += m2[t] + 256.0f * dm * dm; }
            S[row] = (f32x2v){mean, 1.0f / sqrtf(q / (256.0f * (float)ntn) + eps)};
        }
        asm volatile("s_waitcnt lgkmcnt(0)" ::: "memory"); __builtin_amdgcn_s_barrier(); asm volatile("" ::: "memory");
        return bad;
    }
};
struct EpiLnRes {
    static constexpr bool PERM = false, AFTER_DRAIN = true;
    const float* base; float* out; int ldc; const float* bias; PanelStats st; unsigned poison;
    __device__ __forceinline__ void fused(f32x4 (&acc)[2][2][4][2], const Unit& u, int wr, int wc, int fr, int fq, PG8_LAS unsigned char* lds, int wid, int lane) const {
        typedef float f32x2v __attribute__((ext_vector_type(2)));
        const PG8_LAS f32x2v* S = (const PG8_LAS f32x2v*)(lds + 8192);
        const int col0 = u.pn * BM + wc * 32 + 4 * fq;
#pragma unroll
        for (int bj = 0; bj < 2; ++bj)
#pragma unroll
            for (int n = 0; n < 2; ++n) { const f32x4 bv = bias ? *(const f32x4*)(bias + col0 + bj * HALF + n * 16) : (f32x4){0.f, 0.f, 0.f, 0.f};
#pragma unroll
                for (int ai = 0; ai < 2; ++ai)
#pragma unroll
                    for (int m = 0; m < 4; ++m) acc[ai][bj][m][n] += bv; }
        f32x4 pre[4][2][2];
#pragma unroll
        for (int m = 0; m < 4; ++m) { const size_t off = (size_t)(u.pm * BM + wr * 64 + m * 16 + fr) * ldc + col0;
#pragma unroll
            for (int bj = 0; bj < 2; ++bj)
#pragma unroll
                for (int n = 0; n < 2; ++n) pre[m][bj][n] = *(const f32x4*)(base + off + bj * HALF + n * 16); }
        const bool bad = st.run(acc, u, wr, wc, fr, fq, lds, wid, lane) || poison != 0u;
        const float qnan = __builtin_nanf("");
#pragma unroll
        for (int ai = 0; ai < 2; ++ai)
#pragma unroll
            for (int m = 0; m < 4; ++m) { const int r = ai * HALF + wr * 64 + m * 16 + fr; const f32x2v sr = S[r]; const size_t off = (size_t)(u.pm * BM + r) * ldc + col0;
#pragma unroll
                for (int bj = 0; bj < 2; ++bj)
#pragma unroll
                    for (int n = 0; n < 2; ++n) { const f32x4 bs = ai == 0 ? pre[m][bj][n] : *(const f32x4*)(base + off + bj * HALF + n * 16); f32x4 o = bs + (acc[ai][bj][m][n] - sr.x) * sr.y;
                        if (bad) o = (f32x4){qnan, qnan, qnan, qnan}; *(f32x4*)(out + off + bj * HALF + n * 16) = o; }
                if (m & 1) asm volatile("" ::: "memory"); }
    }
};
struct EpiLnResLn {
    static constexpr bool PERM = false, AFTER_DRAIN = true;
    const float* base; float* out; bf16_t* xn; int ldc; const float* bias; PanelStats st1, st2; unsigned poison;
    __device__ __forceinline__ void fused(f32x4 (&acc)[2][2][4][2], const Unit& u, int wr, int wc, int fr, int fq, PG8_LAS unsigned char* lds, int wid, int lane) const {
        typedef float f32x2v __attribute__((ext_vector_type(2))); typedef unsigned u32x2v __attribute__((ext_vector_type(2)));
        const PG8_LAS f32x2v* S = (const PG8_LAS f32x2v*)(lds + 8192);
        const int col0 = u.pn * BM + wc * 32 + 4 * fq;
#pragma unroll
        for (int bj = 0; bj < 2; ++bj)
#pragma unroll
            for (int n = 0; n < 2; ++n) { const f32x4 bv = bias ? *(const f32x4*)(bias + col0 + bj * HALF + n * 16) : (f32x4){0.f, 0.f, 0.f, 0.f};
#pragma unroll
                for (int ai = 0; ai < 2; ++ai)
#pragma unroll
                    for (int m = 0; m < 4; ++m) acc[ai][bj][m][n] += bv; }
        bool bad = st1.run(acc, u, wr, wc, fr, fq, lds, wid, lane) || poison != 0u;
        const float qnan = __builtin_nanf("");
#pragma unroll
        for (int ai = 0; ai < 2; ++ai)
#pragma unroll
            for (int m = 0; m < 4; ++m) { const int r = ai * HALF + wr * 64 + m * 16 + fr; const f32x2v sr = S[r]; const size_t off = (size_t)(u.pm * BM + r) * ldc + col0;
#pragma unroll
                for (int bj = 0; bj < 2; ++bj)
#pragma unroll
                    for (int n = 0; n < 2; ++n) { const f32x4 bs = *(const f32x4*)(base + off + bj * HALF + n * 16); acc[ai][bj][m][n] = bs + (acc[ai][bj][m][n] - sr.x) * sr.y; }
                asm volatile("" : "+v"(acc[ai][0][m][0]), "+v"(acc[ai][0][m][1]), "+v"(acc[ai][1][m][0]), "+v"(acc[ai][1][m][1]));
                if (m & 1) asm volatile("" ::: "memory"); }
        const bool bad1 = bad;
        bad = st2.run(acc, u, wr, wc, fr, fq, lds, wid, lane) || bad;
#pragma unroll
        for (int ai = 0; ai < 2; ++ai)
#pragma unroll
            for (int m = 0; m < 4; ++m) { const int r = ai * HALF + wr * 64 + m * 16 + fr; const f32x2v sr = S[r]; const size_t off = (size_t)(u.pm * BM + r) * ldc + col0;
#pragma unroll
                for (int bj = 0; bj < 2; ++bj)
#pragma unroll
                    for (int n = 0; n < 2; ++n) { const f32x4 x1 = acc[ai][bj][m][n]; *(f32x4*)(out + off + bj * HALF + n * 16) = bad1 ? (f32x4){qnan, qnan, qnan, qnan} : x1;
                        const f32x4 o = (x1 - sr.x) * sr.y; u32x2v w; w.x = cvt_pk_bf16(o[0], o[1]); w.y = cvt_pk_bf16(o[2], o[3]);
                        if (bad) { w.x = 0x7fc07fc0u; w.y = 0x7fc07fc0u; } *(u32x2v*)(xn + off + bj * HALF + n * 16) = w; }
                asm volatile("" ::: "memory"); }
    }
};

template <class Epi, class Sched, bool ALIGN_EPI = false, bool SP2 = false>
__device__ __forceinline__ void gemm_phase(PG8_LAS unsigned char* lds, const Gemm g, const Sched& S, const Epi& E) {
    int tid_ = threadIdx.x; asm volatile("" : "+v"(tid_));
    const int tid = tid_, wid = __builtin_amdgcn_readfirstlane(tid >> 6), lane = tid & 63, wr = wid >> 2, wc = wid & 3, fr = lane & 15, fq = lane >> 4;
    const int K = g.K, nt = K / BK;
    unsigned voffA[2], voffB[2];
#pragma unroll
    for (int i = 0; i < 2; ++i) { int R, C; stage_rc(tid * 16 + i * 8192, R, C); const int Rb = Epi::PERM ? ((R & ~31) + perm32(R & 31)) : R;
        voffA[i] = (unsigned)(R * K + C) * 2u; voffB[i] = (unsigned)(Rb * K + C) * 2u; }
    const size_t kstep = (size_t)(BK * 2);
    const size_t hstep = (size_t)HALF * K * 2;
    const size_t tstep = 2 * hstep;
    const unsigned ldsw = (unsigned)wid * 1024u;
    const int aoff = lds_byte(wr * 64 + fr, fq * 8), boff = lds_byte(wc * 32 + fr, fq * 8);
#define PG8_SA(b, h) (((b) * 2 + (h)) * HTB)
#define PG8_SB(b, h) ((4 + (b) * 2 + (h)) * HTB)
#define PG8_STAGE(bufoff, gbase, voff) do { _Pragma("unroll") for (int _i = 0; _i < 2; ++_i) \
        __builtin_amdgcn_global_load_lds((const unsigned*)((const char*)(gbase) + (voff)[_i]), (PG8_LAS unsigned*)(lds + (bufoff) + ldsw + _i * 8192), 16, 0, 0); } while (0)
#define PG8_LDA(dst, b, h) do { _Pragma("unroll") for (int m = 0; m < 4; ++m) _Pragma("unroll") for (int k = 0; k < 2; ++k) dst[m][k] = *(const PG8_LAS bf16x8*)(lds + PG8_SA(b, h) + aoff + m * 2048 + k * 1024); } while (0)
#define PG8_LDB(dst, b, h) do { _Pragma("unroll") for (int n = 0; n < 2; ++n) _Pragma("unroll") for (int k = 0; k < 2; ++k) dst[n][k] = *(const PG8_LAS bf16x8*)(lds + PG8_SB(b, h) + boff + n * 2048 + k * 1024); } while (0)
#define PG8_MMA(ai, bj, At, Bt) do { __builtin_amdgcn_s_setprio(1); _Pragma("unroll") for (int m = 0; m < 4; ++m) _Pragma("unroll") for (int n = 0; n < 2; ++n) _Pragma("unroll") for (int k = 0; k < 2; ++k) \
        acc[ai][bj][m][n] = __builtin_amdgcn_mfma_f32_16x16x32_bf16(Bt[n][k], At[m][k], acc[ai][bj][m][n], 0, 0, 0); __builtin_amdgcn_s_setprio(0); } while (0)
#define PG8_WAIT_V(n) asm volatile("s_waitcnt vmcnt(" #n ")" ::: "memory")
#define PG8_WAIT_L(n) asm volatile("s_waitcnt lgkmcnt(" #n ")" ::: "memory")
#define PG8_BAR __builtin_amdgcn_s_barrier()
#define PG8_SCHED __builtin_amdgcn_sched_barrier(0)
    Unit cur, nxt; int ui = 0;
    if (!S.next(0, cur)) return;
    f32x4 acc[2][2][4][2];
#pragma unroll
    for (int a = 0; a < 2; ++a)
#pragma unroll
        for (int b = 0; b < 2; ++b)
#pragma unroll
            for (int m = 0; m < 4; ++m)
#pragma unroll
                for (int n = 0; n < 2; ++n) acc[a][b][m][n] = (f32x4){0.f, 0.f, 0.f, 0.f};
    bf16x8 At[4][2], B0[2][2], B1[2][2];
    const char* cA = (const char*)g.A + (size_t)cur.pm * tstep; const char* cB = (const char*)g.Bt + (size_t)cur.pn * tstep;
    S.a_ready(cur);
    if constexpr (SP2) {
        PG8_STAGE(PG8_SB(0, 0), cB, voffB); PG8_STAGE(PG8_SB(0, 1), cB + hstep, voffB); PG8_STAGE(PG8_SA(0, 0), cA, voffA); PG8_STAGE(PG8_SA(0, 1), cA + hstep, voffA);
        if (wr == 1) PG8_BAR;
        PG8_WAIT_V(2); PG8_BAR;
        PG8_STAGE(PG8_SB(1, 0), cB + kstep, voffB); PG8_STAGE(PG8_SA(1, 0), cA + kstep, voffA); PG8_STAGE(PG8_SB(1, 1), cB + hstep + kstep, voffB);
        PG8_WAIT_V(6); PG8_BAR;
    } else {
        PG8_STAGE(PG8_SB(0, 0), cB, voffB); PG8_STAGE(PG8_SA(0, 0), cA, voffA); PG8_STAGE(PG8_SB(0, 1), cB + hstep, voffB); PG8_STAGE(PG8_SA(0, 1), cA + hstep, voffA);
        if (wr == 1) PG8_BAR;
        PG8_WAIT_V(4); PG8_BAR;
        PG8_STAGE(PG8_SB(1, 0), cB + kstep, voffB); PG8_STAGE(PG8_SA(1, 0), cA + kstep, voffA); PG8_STAGE(PG8_SB(1, 1), cB + hstep + kstep, voffB);
        PG8_WAIT_V(6); PG8_BAR;
    }
    for (;;) {
        const bool has_next = S.next(ui + 1, nxt);
        const char* nA = has_next ? (const char*)g.A + (size_t)nxt.pm * tstep : cA; const char* nB = has_next ? (const char*)g.Bt + (size_t)nxt.pn * tstep : cB;
        for (int t = 0; t < nt; t += 2) {
            const bool last = (t == nt - 2);
            const char* a1 = cA + (size_t)(t + 1) * kstep;
            const char* a2 = last ? nA : cA + (size_t)(t + 2) * kstep; const char* b2 = last ? nB : cB + (size_t)(t + 2) * kstep;
            const char* a3 = a2 + kstep; const char* b3 = b2 + kstep;
            if (last && has_next) S.a_ready(nxt);
            if constexpr (SP2) {
            PG8_LDB(B0, 0, 0); PG8_LDB(B1, 0, 1); PG8_SCHED; PG8_LDA(At, 0, 0); PG8_STAGE(PG8_SA(1, 1), a1 + hstep, voffA);
            PG8_WAIT_V(8); PG8_WAIT_L(0); PG8_BAR; PG8_MMA(0, 0, At, B0); PG8_MMA(0, 1, At, B1); PG8_BAR; PG8_SCHED;
            PG8_LDA(At, 0, 1); PG8_STAGE(PG8_SB(0, 0), b2, voffB); PG8_STAGE(PG8_SB(0, 1), b2 + hstep, voffB); PG8_STAGE(PG8_SA(0, 0), a2, voffA);
            PG8_WAIT_V(8); PG8_WAIT_L(0); PG8_BAR; PG8_MMA(1, 0, At, B0); PG8_MMA(1, 1, At, B1); PG8_BAR; PG8_SCHED;
            PG8_LDB(B0, 1, 0); PG8_LDB(B1, 1, 1); PG8_SCHED; PG8_LDA(At, 1, 0); PG8_STAGE(PG8_SA(0, 1), a2 + hstep, voffA);
            PG8_WAIT_V(8); PG8_WAIT_L(0); PG8_BAR; PG8_MMA(0, 0, At, B0); PG8_MMA(0, 1, At, B1); PG8_BAR; PG8_SCHED;
            PG8_LDA(At, 1, 1); PG8_STAGE(PG8_SB(1, 0), b3, voffB); PG8_STAGE(PG8_SB(1, 1), b3 + hstep, voffB); PG8_STAGE(PG8_SA(1, 0), a3, voffA);
            PG8_WAIT_V(8); PG8_WAIT_L(0); PG8_BAR; PG8_MMA(1, 0, At, B0); PG8_MMA(1, 1, At, B1); PG8_BAR; PG8_SCHED;
            } else {
            PG8_LDB(B0, 0, 0); PG8_SCHED; PG8_LDA(At, 0, 0); PG8_STAGE(PG8_SA(1, 1), a1 + hstep, voffA);
            PG8_WAIT_L(8); PG8_BAR; PG8_WAIT_L(0); PG8_MMA(0, 0, At, B0); PG8_BAR; PG8_SCHED;
            PG8_LDB(B1, 0, 1); PG8_STAGE(PG8_SB(0, 0), b2, voffB);
            PG8_BAR; PG8_WAIT_L(0); PG8_MMA(0, 1, At, B1); PG8_BAR;
            PG8_LDA(At, 0, 1); PG8_STAGE(PG8_SA(0, 0), a2, voffA);
            PG8_BAR; PG8_WAIT_L(0); PG8_MMA(1, 0, At, B0); PG8_BAR; PG8_SCHED;
            PG8_STAGE(PG8_SB(0, 1), b2 + hstep, voffB);
            PG8_WAIT_V(6); PG8_BAR; PG8_MMA(1, 1, At, B1); PG8_BAR;
            PG8_LDB(B0, 1, 0); PG8_SCHED; PG8_LDA(At, 1, 0); PG8_STAGE(PG8_SA(0, 1), a2 + hstep, voffA);
            PG8_WAIT_L(8); PG8_BAR; PG8_WAIT_L(0); PG8_MMA(0, 0, At, B0); PG8_BAR; PG8_SCHED;
            PG8_LDB(B1, 1, 1); PG8_STAGE(PG8_SB(1, 0), b3, voffB);
            PG8_BAR; PG8_WAIT_L(0); PG8_MMA(0, 1, At, B1); PG8_BAR;
            PG8_LDA(At, 1, 1); PG8_STAGE(PG8_SA(1, 0), a3, voffA);
            PG8_BAR; PG8_WAIT_L(0); PG8_MMA(1, 0, At, B0); PG8_BAR; PG8_SCHED;
            PG8_STAGE(PG8_SB(1, 1), b3 + hstep, voffB);
            PG8_WAIT_V(6); PG8_BAR; PG8_MMA(1, 1, At, B1); PG8_BAR;
            }
        }
        if constexpr (ALIGN_EPI) { if (wr == 0) PG8_BAR; }
        if constexpr (!Epi::AFTER_DRAIN) { E(acc, cur, wr, wc, fr, fq); S.done(cur); }
        if (!has_next) break;
#pragma unroll
        for (int a = 0; a < 2; ++a)
#pragma unroll
            for (int b = 0; b < 2; ++b)
#pragma unroll
                for (int m = 0; m < 4; ++m)
#pragma unroll
                    for (int n = 0; n < 2; ++n) acc[a][b][m][n] = (f32x4){0.f, 0.f, 0.f, 0.f};
        cur = nxt; cA = nA; cB = nB; ++ui;
        if constexpr (ALIGN_EPI) { if (wr == 1) PG8_BAR; }
    }
    PG8_WAIT_V(0);
    if constexpr (!ALIGN_EPI) { if (wr == 0) PG8_BAR; }
    PG8_BAR;
    if constexpr (Epi::AFTER_DRAIN) { E.fused(acc, cur, wr, wc, fr, fq, lds, wid, lane); S.done(cur); }
#undef PG8_SA
#undef PG8_SB
#undef PG8_STAGE
#undef PG8_LDA
#undef PG8_LDB
#undef PG8_MMA
#undef PG8_WAIT_V
#undef PG8_WAIT_L
#undef PG8_BAR
#undef PG8_SCHED
}
}
namespace pg8 {
struct EpiF32 {
    static constexpr bool PERM = false, AFTER_DRAIN = false;
    float* C; int ldc;
    __device__ __forceinline__ void operator()(const f32x4 (&acc)[2][2][4][2], const Unit& u, int wr, int wc, int fr, int fq) const {
        const int row0 = u.pm * BM + wr * 64 + fr, col0 = u.pn * BM + wc * 32 + 4 * fq;
#pragma unroll
        for (int ai = 0; ai < 2; ++ai)
#pragma unroll
            for (int m = 0; m < 4; ++m) { float* rowp = C + (size_t)(row0 + ai * HALF + m * 16) * ldc + col0;
#pragma unroll
                for (int bj = 0; bj < 2; ++bj)
#pragma unroll
                    for (int n = 0; n < 2; ++n) *(f32x4*)(rowp + bj * HALF + n * 16) = acc[ai][bj][m][n]; }
    }
};
}
#ifndef PG8_SP2
#define PG8_SP2 true
#endif
#ifndef PG8_ALIGN
#define PG8_ALIGN true
#endif
#endif
constexpr int BATCH = 4, SEQ = 2048, DM = 2048, DEPTH = 2;
constexpr int MTOK = BATCH * SEQ;
constexpr int DBR = 512;
constexpr int D_IN = 6016, LDP = 6144;
constexpr int CA_R = 0, CA_K = 512, CA_V = 1024, CA_WD = 1536, CA_AD = 1600, A_COLS = 1664;
constexpr int CB_Q = 1664, CB_K = 2176, CB_V = 2304;
constexpr int CC_Z = 2432;
constexpr int CD_U = 2944, CD_V = 3456;
constexpr int CG = 3968;
constexpr float NORM_EPS = 1e-6f, LN_EPS = 1e-5f, GN_EPS = 64e-5f;

typedef unsigned short bf16;
#define HD __host__ __device__ __forceinline__
HD float bf2f(bf16 v) { return __builtin_bit_cast(float, ((unsigned)v) << 16); }
HD bf16 f2bf(float f) { unsigned u = __builtin_bit_cast(unsigned, f); return (bf16)((u + 0x7fffu + ((u >> 16) & 1u)) >> 16); }
HD float silu_f(float g) { return g / (1.f + expf(-g)); }
HD float gelu_f(float x) { return 0.5f * x * (1.f + erff(x * 0.70710678118654752f)); }
HD float sigmoid_f(float x) { return 1.f / (1.f + expf(-x)); }
HD float softplus_f(float x) { return x > 20.f ? x : log1pf(expf(x)); }

struct NP {
    int B, T;
    const bf16* proj;
    bf16* Y;
    float *TW, *R, *W, *K2, *V, *A, *Bv, *YR, *POOLED, *VN;
    const float *mu, *w0, *w_up, *a0, *a_up, *k_k, *k_a, *r_k, *ln_w, *ln_b, *sinks, *pool_w, *pool_scale, *sgu_norm_w, *sgu_w, *sgu_b;
};
HD float pj(const NP& p, int m, int col) { return bf2f(p.proj[(size_t)m * LDP + col]); }
HD float zshift(const NP& p, int m, int t, int col) { const float z = pj(p, m, col); const float zp = t > 0 ? pj(p, m - 1, col) : 0.f; return z + p.mu[col] * (zp - z); }

HD void n_tw(const NP& p, int item) {
    const int m = item >> 7, j = item & 127, t = m % p.T;
    const float z = zshift(p, m, t, CA_WD + j);
    p.TW[item] = j < 64 ? tanhf(z) : z;
}
HD void n_pool_pre(const NP& p, int item) {
    const int m = item >> 9, c = item & 511, g = c >> 7, t = m % p.T, w = 2 << g;
    const int cnt = (t + 1) < w ? (t + 1) : w;
    float s = 0.f;
    for (int q = 0; q < cnt; ++q) s += pj(p, m - q, CC_Z + c);
    p.POOLED[item] = s / (float)cnt - pj(p, m, CC_Z + c);
}
HD void n_sgu_pre(const NP& p, int m) {
    float s = 0.f, ss = 0.f;
    for (int c = 0; c < DBR; ++c) { const float g = gelu_f(pj(p, m, CD_V + c)); s += g; ss += g * g; p.VN[(size_t)m * DBR + c] = g; }
    const float mean = s * (1.f / DBR); float var = ss * (1.f / DBR) - mean * mean; var = var < 0.f ? 0.f : var;
    const float rstd = 1.f / sqrtf(var + LN_EPS);
    for (int c = 0; c < DBR; ++c) { const size_t i = (size_t)m * DBR + c; p.VN[i] = (p.VN[i] - mean) * rstd * p.sgu_norm_w[c]; }
}
HD void n_rwkv_prep(const NP& p, int item) {
    const int m = item >> 9, c = item & 511, t = m % p.T;
    const float r = zshift(p, m, t, CA_R + c), k = zshift(p, m, t, CA_K + c), v = zshift(p, m, t, CA_V + c);
    float wl = p.w0[c], al = p.a0[c];
    const float* tw = p.TW + (size_t)m * 128;
    for (int j = 0; j < 64; ++j) { wl += tw[j] * p.w_up[j * DBR + c]; al += tw[64 + j] * p.a_up[j * DBR + c]; }
    const float w_log = -softplus_f(-wl) - 0.5f;
    const float decay = expf(-expf(w_log));
    const float a = sigmoid_f(al);
    p.R[item] = r; p.W[item] = decay; p.V[item] = v;
    p.K2[item] = k * (1.f + (a - 1.f) * p.k_a[c]);
    p.A[item] = k * p.k_k[c];
    p.Bv[item] = a;
}
HD void n_rwkv_fin(const NP& p, int item) {
    const size_t base = (size_t)item * 64;
    float ss = 0.f;
    for (int j = 0; j < 64; ++j) { const float x = p.A[base + j]; ss += x * x; }
    const float nrm = sqrtf(ss), inv = 1.f / (nrm > 1e-12f ? nrm : 1e-12f);
    for (int j = 0; j < 64; ++j) { const float kk = p.A[base + j] * inv, a = p.Bv[base + j]; p.A[base + j] = -kk; p.Bv[base + j] = kk * a; }
}
HD void n_rwkv_scan(const NP& p, int item) {
    const int bh = item >> 6, i = item & 63, b = bh >> 3, h = bh & 7;
    float S[64];
#pragma unroll
    for (int j = 0; j < 64; ++j) S[j] = 0.f;
    for (int t = 0; t < p.T; ++t) {
        const size_t base = ((size_t)(b * p.T + t)) * DBR + h * 64;
        const float* A = p.A + base; const float* Bv = p.Bv + base; const float* W = p.W + base; const float* K2 = p.K2 + base; const float* R = p.R + base;
        const float v = p.V[base + i];
        float sa = 0.f;
#pragma unroll
        for (int j = 0; j < 64; ++j) sa += S[j] * A[j];
        float y = 0.f;
#pragma unroll
        for (int j = 0; j < 64; ++j) { S[j] = S[j] * W[j] + sa * Bv[j] + v * K2[j]; y += S[j] * R[j]; }
        p.YR[base + i] = y;
    }
}
HD void n_rwkv_post(const NP& p, int item) {
    const int m = item >> 3, h = item & 7; const size_t base = (size_t)m * DBR + h * 64;
    float s = 0.f, rk = 0.f;
    for (int c = 0; c < 64; ++c) { s += p.YR[base + c]; rk += p.R[base + c] * p.K2[base + c] * p.r_k[h * 64 + c]; }
    const float mean = s * (1.f / 64.f); float q = 0.f;
    for (int c = 0; c < 64; ++c) { const float d = p.YR[base + c] - mean; q += d * d; }
    const float rstd = 1.f / sqrtf(q * (1.f / 64.f) + GN_EPS);
    for (int c = 0; c < 64; ++c) {
        const int ch = h * 64 + c;
        const float o = (p.YR[base + c] - mean) * rstd * p.ln_w[ch] + p.ln_b[ch] + rk * p.V[base + c];
        p.Y[(size_t)m * DM + ch] = f2bf(o * silu_f(pj(p, m, CG + ch)));
    }
}
HD void n_swa(const NP& p, int item) {
    const int m = item >> 3, h = item & 7, kvh = h >> 2, t = m % p.T;
    const float slope = exp2f(-(float)(h + 1));
    float q[64];
#pragma unroll
    for (int d = 0; d < 64; ++d) q[d] = pj(p, m, CB_Q + h * 64 + d) * 0.125f;
    const int nk = t < 127 ? t + 1 : 128;
    float mx = p.sinks[h];
    for (int dist = 0; dist < nk; ++dist) {
        const bf16* kr = p.proj + (size_t)(m - dist) * LDP + CB_K + kvh * 64;
        float s = 0.f;
#pragma unroll
        for (int d = 0; d < 64; ++d) s += q[d] * bf2f(kr[d]);
        s -= slope * (float)dist;
        mx = s > mx ? s : mx;
    }
    float o[64];
#pragma unroll
    for (int d = 0; d < 64; ++d) o[d] = 0.f;
    float den = expf(p.sinks[h] - mx);
    for (int dist = 0; dist < nk; ++dist) {
        const bf16* kr = p.proj + (size_t)(m - dist) * LDP + CB_K + kvh * 64;
        const bf16* vr = p.proj + (size_t)(m - dist) * LDP + CB_V + kvh * 64;
        float s = 0.f;
#pragma unroll
        for (int d = 0; d < 64; ++d) s += q[d] * bf2f(kr[d]);
        s -= slope * (float)dist;
        const float pr = expf(s - mx); den += pr;
#pragma unroll
        for (int d = 0; d < 64; ++d) o[d] += pr * bf2f(vr[d]);
    }
    const float inv = 1.f / den;
#pragma unroll
    for (int d = 0; d < 64; ++d) { const int ch = DBR + h * 64 + d; p.Y[(size_t)m * DM + ch] = f2bf(o[d] * inv * silu_f(pj(p, m, CG + ch))); }
}
HD void n_pool_out(const NP& p, int item) {
    const int m = item >> 9, c = item & 511, g = c >> 7, d = c & 127;
    const float* pl = p.POOLED + (size_t)m * DBR + g * 128; const float* w = p.pool_w + (size_t)g * 128 * 128 + d;
    float y = 0.f;
    for (int cc = 0; cc < 128; ++cc) y += pl[cc] * w[cc * 128];
    y *= p.pool_scale[c];
    const int ch = 2 * DBR + c;
    p.Y[(size_t)m * DM + ch] = f2bf(y * silu_f(pj(p, m, CG + ch)));
}
HD void n_sgu_out(const NP& p, int item) {
    const int m = item >> 9, c = item & 511, g = c >> 7, t = m % p.T, i = t & 127, m0 = m - i;
    const float* wrow = p.sgu_w + ((size_t)g * 128 + i) * 128;
    float s = p.sgu_b[g * 128 + i];
    for (int j = 0; j <= i; ++j) s += wrow[j] * p.VN[(size_t)(m0 + j) * DBR + c];
    const float u = gelu_f(pj(p, m, CD_U + c));
    const int ch = 3 * DBR + c;
    p.Y[(size_t)m * DM + ch] = f2bf(u * s * silu_f(pj(p, m, CG + ch)));
}
#ifndef HOST_TEST
constexpr int NWAVES = 8;
#ifndef MK_ONE_LAUNCH
#define MK_ONE_LAUNCH 1
#endif
constexpr int NPL = 8;
constexpr int NPHASES = 1 + DEPTH * NPL;

constexpr size_t MiB = 1u << 20;
constexpr size_t WS_CTL = 0, CTL_ZERO_BYTES = 1 * MiB;
constexpr size_t WS_WIN = 1 * MiB;
constexpr size_t WS_WOUT = WS_WIN + 48 * MiB;
constexpr size_t WS_XN = WS_WOUT + 16 * MiB;
constexpr size_t WS_PROJ = WS_XN + 32 * MiB;
constexpr size_t WS_O = WS_PROJ;
constexpr size_t WS_Y = WS_PROJ + 96 * MiB;
constexpr size_t WS_RW = WS_Y + 32 * MiB;
constexpr size_t WS_POOLED = WS_RW + 112 * MiB;
constexpr size_t WS_VN = WS_POOLED + 16 * MiB;
constexpr size_t WS_TW = WS_VN + 16 * MiB;
constexpr size_t WS_END = WS_TW + 4 * MiB;
constexpr int CW_TMO = 0, CW_CODE = 1, CW_BAR = 4096;

constexpr int RING_OFF = 0, RING_BYTES = 131072;
constexpr int LDSCTL_OFF = RING_BYTES, MISC_OFF = LDSCTL_OFF + 320;
constexpr int LDS_BYTES = 147456;

#define GAS __attribute__((address_space(1)))
#define LAS __attribute__((address_space(3)))
typedef unsigned v4u __attribute__((ext_vector_type(4)));
typedef float f32x4 __attribute__((ext_vector_type(4)));
typedef GAS unsigned gu32;
#define RLX_AGENT __ATOMIC_RELAXED, __HIP_MEMORY_SCOPE_AGENT
#define LDS_WAIT() asm volatile("s_waitcnt lgkmcnt(0)" ::: "memory")
#define VM_WAIT() asm volatile("s_waitcnt vmcnt(0)" ::: "memory")
__device__ __forceinline__ unsigned pk2(float lo, float hi) { return (unsigned)f2bf(lo) | ((unsigned)f2bf(hi) << 16); }
#define XB_TMO      128
#define XB_XCNT(j)  (256  + 64 * (j))
#define XB_XSUB(j)  (1280 + 64 * (j))
#define XB_XGEN(j)  (2304 + 64 * (j))
#define XB_TOP      3328
#define XB_TOPGEN   3392
#define XCD_BAR_WORDS 3456
#define XB_SPIN_CAP (1u << 18)

__device__ __forceinline__ unsigned xb_ld(unsigned* p)              { return __hip_atomic_load(p, __ATOMIC_RELAXED, __HIP_MEMORY_SCOPE_AGENT); }
__device__ __forceinline__ unsigned xb_add(unsigned* p, unsigned v) { return __hip_atomic_fetch_add(p, v, __ATOMIC_RELAXED, __HIP_MEMORY_SCOPE_AGENT); }
__device__ __forceinline__ unsigned xb_xcc_id() { return (unsigned)__builtin_amdgcn_s_getreg((3 << 11) | 20) & 0xFu; }
#define XB_SPIN(cond, bar) do { unsigned _sp = 0; while (cond) { __builtin_amdgcn_s_sleep(1); \
    if ((++_sp & 255u) == 0u) { if (xb_ld(&(bar)[XB_TMO])) break; if (_sp > XB_SPIN_CAP) { atomicAdd(&(bar)[XB_TMO], 1u); break; } } } } while (0)

struct XcdBarrier {
    unsigned* bar; unsigned x;
    volatile LAS unsigned* st;
};

__device__ __forceinline__ XcdBarrier xcd_barrier_post(unsigned* bar, volatile LAS unsigned* st) {
    XcdBarrier b; b.bar = bar; b.x = xb_xcc_id(); b.st = st;
    if (threadIdx.x == 0) (void)xb_add(&bar[XB_XCNT(b.x)], 1u);
    return b;
}
__device__ __forceinline__ void xcd_barrier_complete(unsigned* bar, unsigned x, unsigned& nloc, unsigned& nx) {
    const unsigned G = gridDim.x * gridDim.y * gridDim.z;
    unsigned sum, cnt, mine, sp = 0u;
    for (;;) {
        sum = 0u; cnt = 0u; mine = 0u;
#pragma unroll
        for (unsigned j = 0; j < 16; ++j) { const unsigned c = xb_ld(&bar[XB_XCNT(j)]); sum += c; cnt += (c > 0u) ? 1u : 0u; mine = (j == x) ? c : mine; }
        if (sum == G) break;
        __builtin_amdgcn_s_sleep(1);
        if ((++sp & 255u) == 0u) { if (xb_ld(&bar[XB_TMO])) break; if (sp > XB_SPIN_CAP) { atomicAdd(&bar[XB_TMO], 1u); break; } }
    }
    nloc = mine > 0u ? mine : 1u; nx = cnt > 0u ? cnt : 1u;
}

__device__ __forceinline__ void xcd_barrier(const XcdBarrier& b) {
    asm volatile("s_waitcnt vmcnt(0)" ::: "memory");
    __syncthreads();
    if (threadIdx.x == 0) {
        unsigned* bar = b.bar;
        __builtin_amdgcn_s_waitcnt(0);
        unsigned nloc = b.st[0], nx = b.st[1];
        if (nloc == 0u) { xcd_barrier_complete(bar, b.x, nloc, nx); b.st[0] = nloc; b.st[1] = nx; }
        const unsigned old = xb_add(&bar[XB_XSUB(b.x)], 1u);
        const unsigned gen = old / nloc;
        if (old + 1u == (gen + 1u) * nloc) {
            __builtin_amdgcn_fence(__ATOMIC_RELEASE, "agent");
            asm volatile("s_waitcnt vmcnt(0)" ::: "memory");
            const unsigned og = xb_add(&bar[XB_TOP], 1u);
            const unsigned tg = og / nx;
            if (og + 1u == (tg + 1u) * nx) xb_add(&bar[XB_TOPGEN], 1u);
            else XB_SPIN(xb_ld(&bar[XB_TOPGEN]) == tg, bar);
            __builtin_amdgcn_fence(__ATOMIC_ACQUIRE, "agent");
            xb_add(&bar[XB_XGEN(b.x)], 1u);
            asm volatile("s_waitcnt vmcnt(0)" ::: "memory");
        } else {
            XB_SPIN(xb_ld(&bar[XB_XGEN(b.x)]) == gen, bar);
            __builtin_amdgcn_fence(__ATOMIC_ACQUIRE, "agent");
            asm volatile("s_waitcnt vmcnt(0)" ::: "memory");
        }
    }
    __syncthreads();
}
__device__ __forceinline__ float wave_sum(float v) {
#pragma unroll
    for (int o = 1; o < 64; o <<= 1) v += __shfl_xor(v, o);
    return v;
}
__device__ __forceinline__ void p0_transpose_item(const float* W, int K, int N, bf16* WT, LAS float* scr, int item, int lane) {
    const int nblk = N / 32, kb = item / nblk, nb = item % nblk, k0 = 64 * kb, n0 = 32 * nb;
#pragma unroll 8
    for (int i = 0; i < 32; ++i) { const int kk = 2 * i + (lane >> 5); scr[kk * 33 + (lane & 31)] = W[(size_t)(k0 + kk) * N + n0 + (lane & 31)]; }
    LDS_WAIT(); asm volatile("" ::: "memory");
    const int c = lane & 7;
#pragma unroll
    for (int j = 0; j < 4; ++j) { const int n = (lane >> 3) + 8 * j; const LAS float* s = scr + (8 * c) * 33 + n;
        v4u o; o.x = pk2(s[0 * 33], s[1 * 33]); o.y = pk2(s[2 * 33], s[3 * 33]); o.z = pk2(s[4 * 33], s[5 * 33]); o.w = pk2(s[6 * 33], s[7 * 33]);
        *(GAS v4u*)(WT + (size_t)(n0 + n) * K + k0 + 8 * c) = o; }
    LDS_WAIT(); asm volatile("" ::: "memory");
}
__device__ __forceinline__ void rms_row_to_bf16(const float* xrow, const float* w, bf16* orow, int lane) {
    const GAS f32x4* xr = (const GAS f32x4*)xrow + lane; const GAS f32x4* wr = (const GAS f32x4*)w + lane;
    f32x4 v[8]; float s = 0.f;
#pragma unroll
    for (int j = 0; j < 8; ++j) { v[j] = xr[64 * j]; s += (v[j].x * v[j].x + v[j].y * v[j].y) + (v[j].z * v[j].z + v[j].w * v[j].w); }
    const float rs = 1.f / sqrtf(wave_sum(s) * (1.f / DM) + NORM_EPS);
    GAS unsigned long long* o8 = (GAS unsigned long long*)orow + lane;
#pragma unroll
    for (int j = 0; j < 8; ++j) { const f32x4 ww = wr[64 * j];
        o8[64 * j] = (unsigned long long)pk2(v[j].x * rs * ww.x, v[j].y * rs * ww.y) | ((unsigned long long)pk2(v[j].z * rs * ww.z, v[j].w * rs * ww.w) << 32); }
}
__device__ __forceinline__ void post_row(const float* orow, const float* xin, const float* post_w, float* xout, const float* pre_w_next, bf16* xn, int lane) {
    const GAS f32x4* op = (const GAS f32x4*)orow + lane; const GAS f32x4* xp = (const GAS f32x4*)xin + lane; const GAS f32x4* pw = (const GAS f32x4*)post_w + lane;
    f32x4 v[8]; float s = 0.f;
#pragma unroll
    for (int j = 0; j < 8; ++j) { v[j] = op[64 * j]; s += (v[j].x * v[j].x + v[j].y * v[j].y) + (v[j].z * v[j].z + v[j].w * v[j].w); }
    const float rs = 1.f / sqrtf(wave_sum(s) * (1.f / DM) + NORM_EPS);
    float s2 = 0.f;
    GAS f32x4* xo = (GAS f32x4*)xout + lane;
#pragma unroll
    for (int j = 0; j < 8; ++j) { const f32x4 xx = xp[64 * j], ww = pw[64 * j]; v[j] = xx + v[j] * rs * ww; xo[64 * j] = v[j];
        s2 += (v[j].x * v[j].x + v[j].y * v[j].y) + (v[j].z * v[j].z + v[j].w * v[j].w); }
    if (pre_w_next) {
        const float rs2 = 1.f / sqrtf(wave_sum(s2) * (1.f / DM) + NORM_EPS);
        const GAS f32x4* wr = (const GAS f32x4*)pre_w_next + lane; GAS unsigned long long* o8 = (GAS unsigned long long*)xn + lane;
#pragma unroll
        for (int j = 0; j < 8; ++j) { const f32x4 ww = wr[64 * j];
            o8[64 * j] = (unsigned long long)pk2(v[j].x * rs2 * ww.x, v[j].y * rs2 * ww.y) | ((unsigned long long)pk2(v[j].z * rs2 * ww.z, v[j].w * rs2 * ww.w) << 32); }
    }
}

#ifndef GM
#define GM 3
#endif
#ifndef PHM
#define PHM 1023
#endif
struct Args { const float* in[21]; float* out; unsigned char* ws; int ph_lo, ph_hi; };
__device__ __forceinline__ int opaque_tid() { int t = threadIdx.x; asm volatile("" : "+v"(t)); return t; }
#define TID (opaque_tid())
#define LANE (TID & 63)
#define WAVE (__builtin_amdgcn_readfirstlane(TID >> 6))
#define GRIDN ((int)gridDim.x)
#define VCU ((GRIDN % 8 == 0) ? ((int)blockIdx.x % 8) * (GRIDN / 8) + (int)blockIdx.x / 8 : (int)blockIdx.x)
#define GTID (VCU * (NWAVES * 64) + TID)
#define GTN (GRIDN * NWAVES * 64)
#define GWV (VCU * NWAVES + WAVE)
#define NGWV (GRIDN * NWAVES)
__device__ __forceinline__ NP make_np(const Args& args, int l) {
    unsigned char* ws = args.ws; NP p;
    p.B = BATCH; p.T = SEQ; p.proj = (const bf16*)(ws + WS_PROJ); p.Y = (bf16*)(ws + WS_Y);
    { float* rw = (float*)(ws + WS_RW); const size_t st = (size_t)MTOK * DBR;
      p.R = rw; p.W = rw + st; p.K2 = rw + 2 * st; p.V = rw + 3 * st; p.A = rw + 4 * st; p.Bv = rw + 5 * st; p.YR = rw + 6 * st; }
    p.POOLED = (float*)(ws + WS_POOLED); p.VN = (float*)(ws + WS_VN); p.TW = (float*)(ws + WS_TW);
    p.mu = args.in[4] + l * A_COLS; p.w0 = args.in[5] + l * DBR; p.w_up = args.in[6] + l * 64 * DBR; p.a0 = args.in[7] + l * DBR; p.a_up = args.in[8] + l * 64 * DBR;
    p.k_k = args.in[9] + l * DBR; p.k_a = args.in[10] + l * DBR; p.r_k = args.in[11] + l * DBR; p.ln_w = args.in[12] + l * DBR; p.ln_b = args.in[13] + l * DBR;
    p.sinks = args.in[14] + l * 8; p.pool_w = args.in[15] + l * 4 * 128 * 128; p.pool_scale = args.in[16] + l * DBR; p.sgu_norm_w = args.in[17] + l * DBR;
    p.sgu_w = args.in[18] + l * 4 * 128 * 128; p.sgu_b = args.in[19] + l * 4 * 128;
    return p;
}
__global__ void __launch_bounds__(NWAVES * 64, 2) skel_fwd(Args args) {
    extern __shared__ __attribute__((aligned(16))) unsigned char lds[];
    LAS unsigned char* ldsp = (LAS unsigned char*)lds;
    for (int u = TID; u < (LDS_BYTES - LDSCTL_OFF) / 4; u += NWAVES * 64) ((LAS unsigned*)(ldsp + LDSCTL_OFF))[u] = 0u;
    __syncthreads();
#if MK_ONE_LAUNCH
    XcdBarrier bar = xcd_barrier_post((unsigned*)(args.ws + WS_CTL) + CW_BAR, (volatile LAS unsigned*)(ldsp + MISC_OFF) + 8);
#define GRID_BAR() xcd_barrier(bar)
#else
#define GRID_BAR() do { } while (0)
#endif
#define IN(k) (args.ph_lo <= (k) && (k) < args.ph_hi)
#define SEAM(k) do { if (IN((k) + 1)) GRID_BAR(); } while (0)

    if (IN(0)) {
        bf16* Win_t = (bf16*)(args.ws + WS_WIN); bf16* Wout_t = (bf16*)(args.ws + WS_WOUT); bf16* XN = (bf16*)(args.ws + WS_XN);
        const int lane = LANE, gw = GWV, NGW = NGWV;
        LAS float* scr = (LAS float*)(ldsp + RING_OFF + WAVE * 16384);
        constexpr int I_IN = (DM / 64) * (D_IN / 32), I_OUT = (DM / 64) * (DM / 32), NITEMS = DEPTH * (I_IN + I_OUT);
        for (int it = gw; it < NITEMS; it += NGW) {
            int r = it; const int l = r / (I_IN + I_OUT); r -= l * (I_IN + I_OUT);
            if (r < I_IN) p0_transpose_item(args.in[3] + (size_t)l * DM * D_IN, DM, D_IN, Win_t + (size_t)l * LDP * DM, scr, r, lane);
            else p0_transpose_item(args.in[20] + (size_t)l * DM * DM, DM, DM, Wout_t + (size_t)l * DM * DM, scr, r - I_IN, lane);
        }
        constexpr int PADV = (LDP - D_IN) * DM / 8;
        for (int i = GTID; i < DEPTH * PADV; i += GTN) { const int l = i / PADV, r = i % PADV; ((GAS v4u*)(Win_t + (size_t)l * LDP * DM + (size_t)D_IN * DM))[r] = (v4u){0u, 0u, 0u, 0u}; }
        for (int m = gw; m < MTOK; m += NGW) rms_row_to_bf16(args.in[0] + (size_t)m * DM, args.in[1], XN + (size_t)m * DM, lane);
        SEAM(0);
    }
    for (int l = 0; l < DEPTH; ++l) {
        const int pb = 1 + l * NPL;
        if ((GM & 1) && IN(pb + 0)) {
            pg8::Gemm g{(const bf16*)(args.ws + WS_XN), (const bf16*)(args.ws + WS_WIN) + (size_t)l * LDP * DM, MTOK, LDP, DM}; pg8::StaticOrder S; S.init(MTOK, LDP, GRIDN, (int)blockIdx.x);
            pg8::EpiBf16<0> E{(bf16*)(args.ws + WS_PROJ), LDP, nullptr, 0, 0, 1.f};
            pg8::gemm_phase<pg8::EpiBf16<0>, pg8::StaticOrder, PG8_ALIGN, PG8_SP2>(ldsp + RING_OFF, g, S, E);
            SEAM(pb + 0);
        }
        if (IN(pb + 1)) {
            const NP p = make_np(args, l); const int gtid = GTID, GT = GTN;
            if (PHM & 1) for (int i = gtid; i < MTOK * 128; i += GT) n_tw(p, i);
            if (PHM & 2) for (int i = gtid; i < MTOK * DBR; i += GT) n_pool_pre(p, i);
            if (PHM & 4) for (int i = gtid; i < MTOK; i += GT) n_sgu_pre(p, i);
            SEAM(pb + 1);
        }
        if (IN(pb + 2)) { const NP p = make_np(args, l); const int gtid = GTID, GT = GTN; if (PHM & 8) for (int i = gtid; i < MTOK * DBR; i += GT) n_rwkv_prep(p, i); SEAM(pb + 2); }
        if (IN(pb + 3)) { const NP p = make_np(args, l); const int gtid = GTID, GT = GTN; if (PHM & 16) for (int i = gtid; i < MTOK * 8; i += GT) n_rwkv_fin(p, i); SEAM(pb + 3); }
        if (IN(pb + 4)) {
            const NP p = make_np(args, l); const int gtid = GTID, GT = GTN;
            if (PHM & 32) for (int i = gtid; i < BATCH * 8 * 64; i += GT) n_rwkv_scan(p, i);
            if (PHM & 64) for (int i = gtid; i < MTOK * 8; i += GT) n_swa(p, i);
            if (PHM & 128) for (int i = gtid; i < MTOK * DBR; i += GT) n_pool_out(p, i);
            if (PHM & 256) for (int i = gtid; i < MTOK * DBR; i += GT) n_sgu_out(p, i);
            SEAM(pb + 4);
        }
        if (IN(pb + 5)) { const NP p = make_np(args, l); const int gtid = GTID, GT = GTN; if (PHM & 512) for (int i = gtid; i < MTOK * 8; i += GT) n_rwkv_post(p, i); SEAM(pb + 5); }
        if ((GM & 2) && IN(pb + 6)) {
            pg8::Gemm g{(const bf16*)(args.ws + WS_Y), (const bf16*)(args.ws + WS_WOUT) + (size_t)l * DM * DM, MTOK, DM, DM}; pg8::StaticOrder S; S.init(MTOK, DM, GRIDN, (int)blockIdx.x);
            pg8::EpiF32 E{(float*)(args.ws + WS_O), DM};
            pg8::gemm_phase<pg8::EpiF32, pg8::StaticOrder, PG8_ALIGN, PG8_SP2>(ldsp + RING_OFF, g, S, E);
            SEAM(pb + 6);
        }
        if (IN(pb + 7)) {
            const float* xin = (l == 0) ? args.in[0] : (const float*)args.out;
            const float* pre_next = (l + 1 < DEPTH) ? args.in[1] + (size_t)(l + 1) * DM : nullptr;
            const float* OB = (const float*)(args.ws + WS_O); bf16* XN = (bf16*)(args.ws + WS_XN);
            const int lane = LANE, NGW = NGWV;
            for (int m = GWV; m < MTOK; m += NGW)
                post_row(OB + (size_t)m * DM, xin + (size_t)m * DM, args.in[2] + (size_t)l * DM, args.out + (size_t)m * DM, pre_next, XN + (size_t)m * DM, lane);
            SEAM(pb + 7);
        }
    }
#undef IN
#undef SEAM
}

extern "C" void kernel_launch(void* const* d_in, const int* in_sizes, int n_in, void* d_out, int out_size, void* d_ws, size_t ws_size, hipStream_t stream) {
    static int grid = 0;
    if (grid == 0) {
        if (n_in != 21 || in_sizes[0] != MTOK * DM || out_size != MTOK * DM || ws_size < WS_END) {
            fprintf(stderr, "kernel_launch: shape/workspace mismatch: n_in %d in0 %d out %d ws %zu (need %zu); nothing launched\n", n_in, n_in > 0 ? in_sizes[0] : -1, out_size, ws_size, (size_t)WS_END); grid = -1; return; }
        int dev = 0, cus = 0;
        if (hipGetDevice(&dev) != hipSuccess || hipDeviceGetAttribute(&cus, hipDeviceAttributeMultiprocessorCount, dev) != hipSuccess) { grid = -1; return; }
        if (hipFuncSetAttribute((const void*)skel_fwd, hipFuncAttributeMaxDynamicSharedMemorySize, LDS_BYTES) != hipSuccess) { fprintf(stderr, "kernel_launch: hipFuncSetAttribute failed\n"); grid = -1; return; }
        (void)hipGetLastError();
        grid = cus;
    }
    if (grid < 0) return;
    if (hipMemsetAsync((char*)d_ws + WS_CTL, 0, CTL_ZERO_BYTES, stream) != hipSuccess) return;
    Args a{};
    for (int i = 0; i < 21; ++i) a.in[i] = (const float*)d_in[i];
    a.out = (float*)d_out; a.ws = (unsigned char*)d_ws;
#if MK_ONE_LAUNCH
    a.ph_lo = 0; a.ph_hi = NPHASES;
    hipLaunchKernelGGL(skel_fwd, dim3(grid), dim3(NWAVES * 64), LDS_BYTES, stream, a);
#else
    for (int ph = 0; ph < NPHASES; ++ph) { a.ph_lo = ph; a.ph_hi = ph + 1; hipLaunchKernelGGL(skel_fwd, dim3(grid), dim3(NWAVES * 64), LDS_BYTES, stream, a); }
#endif
}
#endif
```

```cpp
#include <hip/hip_runtime.h>
#include <cstdio>
#include <cstdint>
#include <cmath>
#ifndef HOST_TEST
namespace pg8 {
#define PG8_LAS __attribute__((address_space(3)))
typedef unsigned short bf16_t;
typedef short bf16x8 __attribute__((ext_vector_type(8)));
typedef float f32x4 __attribute__((ext_vector_type(4)));
typedef unsigned u32x4 __attribute__((ext_vector_type(4)));
constexpr int BM = 256, BK = 64, HALF = 128, HTB = HALF * BK * 2  , STAGE_BYTES = 8 * HTB, NXCD = 8, WGM = 8;

__host__ __device__ __forceinline__ int lds_byte(int r, int c) { const int st = (r >> 4) * 2 + (c >> 5), rr = r & 15, cc = c & 31, ob = rr * 64 + cc * 2; return st * 1024 + (ob ^ (((ob >> 9) & 1) << 5)); }
__host__ __device__ __forceinline__ void stage_rc(int b, int& R, int& C) { const int st = b / 1024, sb = b % 1024, swz = sb ^ (((sb >> 9) & 1) << 5); R = (st >> 1) * 16 + swz / 64; C = (st & 1) * 32 + (swz % 64) / 2; }
__host__ __device__ __forceinline__ int perm32(int rho) { const int n = rho >> 4, i = rho & 15; return 8 * (i >> 2) + 4 * n + (i & 3); }

struct Unit { int pm, pn; };
struct Gemm { const bf16_t* A; const bf16_t* Bt; int M, N, K; };

struct StaticOrder {
    int nM, nN, nwg, G, c;
    __host__ __device__ void init(int M, int N, int G_, int c_) { nM = M / BM; nN = N / BM; nwg = nM * nN; G = G_; c = c_; }
    __host__ __device__ bool next(int i, Unit& u) const {
        const long L = (long)i * G + c; if (L >= nwg) return false;
        int wgid = (int)L; { const int q = nwg / NXCD, r = nwg % NXCD, xcd = wgid % NXCD, off = wgid / NXCD; wgid = (xcd < r ? xcd * (q + 1) : r * (q + 1) + (xcd - r) * q) + off; }
        const int nig = WGM * nN, gid = wgid / nig, fm = gid * WGM, gsz = (nM - fm) < WGM ? (nM - fm) : WGM;
        u.pm = fm + ((wgid % nig) % gsz); u.pn = (wgid % nig) / gsz; return true;
    }
    __device__ __forceinline__ void a_ready(const Unit&) const {}
    __device__ __forceinline__ void done(const Unit&) const {}
};

__device__ __forceinline__ unsigned cvt_pk_bf16(float lo, float hi) { unsigned r; asm volatile("v_cvt_pk_bf16_f32 %0, %1, %2" : "=v"(r) : "v"(lo), "v"(hi)); return r; }
typedef float f32x2 __attribute__((ext_vector_type(2)));
__device__ __forceinline__ f32x2 gelu_pk(f32x2 v) {
    const f32x2 av = __builtin_elementwise_abs(v), d = av * 0.2316418882f + 1.0f;
    f32x2 t; t.x = __builtin_amdgcn_rcpf(d.x); t.y = __builtin_amdgcn_rcpf(d.y);
    f32x2 q = t * 0.5307027145f + (-0.7265760135f); q = q * t + 0.7107068705f; q = q * t + (-0.142248368f); q = q * t + 0.127414796f; q = q * t;
    const f32x2 s = (v * v) * (-0.72134752044f);
    f32x2 e; e.x = __builtin_amdgcn_exp2f(s.x); e.y = __builtin_amdgcn_exp2f(s.y);
    const f32x2 m = v * (q * e), r = v - m;
    f32x2 o; o.x = v.x < 0.f ? m.x : r.x; o.y = v.y < 0.f ? m.y : r.y; return o;
}

template <int ACT  > struct EpiBf16 {
    static constexpr bool PERM = true, AFTER_DRAIN = false; static_assert(ACT == 0 || ACT == 1, "EpiBf16: ACT is 0 (none) or 1 (gelu_pk)");
    bf16_t* O; int ldc; const float* bias; int split_cols; size_t split_stride; float scale0;
    __device__ __forceinline__ void operator()(const f32x4 (&acc)[2][2][4][2], const Unit& u, int wr, int wc, int fr, int fq) const {
        const int row0 = u.pm * BM + wr * 64 + fr; int colt = u.pn * BM; bf16_t* base = O;
        float sc = 1.f; if (split_cols) { const int t = colt / split_cols; base += (size_t)t * split_stride; colt -= t * split_cols; if (t == 0) sc = scale0; }
        const int col0 = colt + wc * 32 + 8 * fq, bcol0 = u.pn * BM + wc * 32 + 8 * fq;
        f32x4 bv[2][2];
#pragma unroll
        for (int bj = 0; bj < 2; ++bj)
#pragma unroll
            for (int n = 0; n < 2; ++n) bv[bj][n] = bias ? *(const f32x4*)(bias + bcol0 + bj * HALF + 4 * n) : (f32x4){0.f, 0.f, 0.f, 0.f};
#pragma unroll
        for (int ai = 0; ai < 2; ++ai)
#pragma unroll
            for (int m = 0; m < 4; ++m) { bf16_t* rowp = base + (size_t)(row0 + ai * HALF + m * 16) * ldc + col0;
#pragma unroll
                for (int bj = 0; bj < 2; ++bj) { f32x4 v0 = acc[ai][bj][m][0] + bv[bj][0], v1 = acc[ai][bj][m][1] + bv[bj][1];
                    if (ACT == 1) { f32x2 a = gelu_pk((f32x2){v0[0], v0[1]}), b = gelu_pk((f32x2){v0[2], v0[3]}), c = gelu_pk((f32x2){v1[0], v1[1]}), d = gelu_pk((f32x2){v1[2], v1[3]});
                        v0 = (f32x4){a.x, a.y, b.x, b.y}; v1 = (f32x4){c.x, c.y, d.x, d.y}; }
                    v0 = v0 * sc; v1 = v1 * sc; u32x4 w; w.x = cvt_pk_bf16(v0[0], v0[1]); w.y = cvt_pk_bf16(v0[2], v0[3]); w.z = cvt_pk_bf16(v1[0], v1[1]); w.w = cvt_pk_bf16(v1[2], v1[3]);
                    *(u32x4*)(rowp + bj * HALF) = w; } }
    }
};

struct PanelStats {
    unsigned* xbuf;
    unsigned* cnt;
    unsigned* tmo;
    int ntn; float eps;
    unsigned code;
    __device__ __forceinline__ bool run(const f32x4 (&v)[2][2][4][2], const Unit& u, int wr, int wc, int fr, int fq, PG8_LAS unsigned char* lds, int wid, int lane) const {
        typedef float f32x2v __attribute__((ext_vector_type(2)));
        PG8_LAS f32x2v* P = (PG8_LAS f32x2v*)lds;
        PG8_LAS f32x2v* S = (PG8_LAS f32x2v*)(lds + 8192);
        PG8_LAS unsigned* flag = (PG8_LAS unsigned*)(lds + 8192 + 2048);
#pragma unroll
        for (int ai = 0; ai < 2; ++ai)
#pragma unroll
            for (int m = 0; m < 4; ++m) {
                float s = 0.f;
#pragma unroll
                for (int bj = 0; bj < 2; ++bj)
#pragma unroll
                    for (int n = 0; n < 2; ++n) { const f32x4 x = v[ai][bj][m][n]; s += (x[0] + x[1]) + (x[2] + x[3]); }
                s += __shfl_xor(s, 16); s += __shfl_xor(s, 32);
                const float mw = s * (1.0f / 64.0f); float q = 0.f;
#pragma unroll
                for (int bj = 0; bj < 2; ++bj)
#pragma unroll
                    for (int n = 0; n < 2; ++n) { const f32x4 d = v[ai][bj][m][n] - mw; q += (d[0] * d[0] + d[1] * d[1]) + (d[2] * d[2] + d[3] * d[3]); }
                q += __shfl_xor(q, 16); q += __shfl_xor(q, 32);
                if (fq == 0) P[(ai * HALF + wr * 64 + m * 16 + fr) * 4 + wc] = (f32x2v){mw, q};
            }
        asm volatile("s_waitcnt lgkmcnt(0)" ::: "memory"); __builtin_amdgcn_s_barrier(); asm volatile("" ::: "memory");
#if defined(BROKEN_EXCHANGE_NO_WAIT)
#warning BROKEN CONTROL BUILD: the row-statistics exchange does not wait; results are wrong by design
        if (blockIdx.x >= 64) { const long long t0_ = clock64(); while (clock64() - t0_ < 60000) __builtin_amdgcn_s_sleep(8); }
#endif
        const int row = wid * 32 + (lane & 31);
        if (lane < 32) {
            const f32x2v a = P[row * 4 + 0], b = P[row * 4 + 1], c = P[row * 4 + 2], d = P[row * 4 + 3];
            const float mt = (a.x + b.x + c.x + d.x) * 0.25f;
            const float da = a.x - mt, db = b.x - mt, dc = c.x - mt, dd = d.x - mt;
            const float m2 = (a.y + b.y) + (c.y + d.y) + 64.0f * ((da * da + db * db) + (dc * dc + dd * dd));
            unsigned long long* slot = (unsigned long long*)xbuf + ((size_t)(u.pm * BM + row) * 4 + u.pn);
            __hip_atomic_store(slot, ((unsigned long long)__float_as_uint(m2) << 32) | __float_as_uint(mt), __ATOMIC_RELAXED, __HIP_MEMORY_SCOPE_AGENT);
        }
        asm volatile("s_waitcnt vmcnt(0)" ::: "memory");
        if (lane == 0) __hip_atomic_fetch_add(cnt + 64 * u.pm, 1u, __ATOMIC_RELAXED, __HIP_MEMORY_SCOPE_AGENT);
        if (wid == 0) {
            bool dead = false; const unsigned long long t0 = __builtin_amdgcn_s_memrealtime(); const unsigned want = 8u * (unsigned)ntn;
            for (;;) {
#if defined(BROKEN_EXCHANGE_NO_WAIT)
                break;
#endif
                if ((unsigned)__builtin_amdgcn_readfirstlane(__hip_atomic_load(cnt + 64 * u.pm, __ATOMIC_RELAXED, __HIP_MEMORY_SCOPE_AGENT)) >= want) break;
                if (__builtin_amdgcn_s_memrealtime() - t0 > 2000000ull) {
                    if (lane == 0) { unsigned expect = 0u; __hip_atomic_compare_exchange_strong(tmo + 1, &expect, code | (unsigned)(u.pm & 0xff), __ATOMIC_RELAXED, __ATOMIC_RELAXED, __HIP_MEMORY_SCOPE_AGENT);
                                     __hip_atomic_store(tmo, 1u, __ATOMIC_RELAXED, __HIP_MEMORY_SCOPE_AGENT); }
                    dead = true; break; }
                __builtin_amdgcn_s_sleep(2);
            }
            __builtin_amdgcn_fence(__ATOMIC_ACQUIRE, "agent");
            if (lane == 0) flag[0] = dead ? 1u : 0u;
        }
        asm volatile("s_waitcnt vmcnt(0) lgkmcnt(0)" ::: "memory"); __builtin_amdgcn_s_barrier(); asm volatile("" ::: "memory");
        const bool bad = flag[0] != 0u;
        if (lane < 32) {
            const unsigned long long* slot = (const unsigned long long*)xbuf + (size_t)(u.pm * BM + row) * 4; float mt[4], m2[4]; float ms = 0.f;
#pragma unroll
            for (int t = 0; t < 4; ++t) { if (t < ntn) { const unsigned long long w = __hip_atomic_load(slot + t, __ATOMIC_RELAXED, __HIP_MEMORY_SCOPE_AGENT); mt[t] = __uint_as_float((unsigned)w); m2[t] = __uint_as_float((unsigned)(w >> 32)); } else { mt[t] = 0.f; m2[t] = 0.f; } ms += mt[t]; }
            const float mean = ms / (float)ntn; float q = 0.f;
#pragma unroll
            for (int t = 0; t < 4; ++t) if (t < ntn) { const float dm = mt[t] - mean; q += m2[t] + 256.0f * dm * dm; }
            S[row] = (f32x2v){mean, 1.0f / sqrtf(q / (256.0f * (float)ntn) + eps)};
        }
        asm volatile("s_waitcnt lgkmcnt(0)" ::: "memory"); __builtin_amdgcn_s_barrier(); asm volatile("" ::: "memory");
        return bad;
    }
};
struct EpiLnRes {
    static constexpr bool PERM = false, AFTER_DRAIN = true;
    const float* base; float* out; int ldc; const float* bias; PanelStats st; unsigned poison;
    __device__ __forceinline__ void fused(f32x4 (&acc)[2][2][4][2], const Unit& u, int wr, int wc, int fr, int fq, PG8_LAS unsigned char* lds, int wid, int lane) const {
        typedef float f32x2v __attribute__((ext_vector_type(2)));
        const PG8_LAS f32x2v* S = (const PG8_LAS f32x2v*)(lds + 8192);
        const int col0 = u.pn * BM + wc * 32 + 4 * fq;
#pragma unroll
        for (int bj = 0; bj < 2; ++bj)
#pragma unroll
            for (int n = 0; n < 2; ++n) { const f32x4 bv = bias ? *(const f32x4*)(bias + col0 + bj * HALF + n * 16) : (f32x4){0.f, 0.f, 0.f, 0.f};
#pragma unroll
                for (int ai = 0; ai < 2; ++ai)
#pragma unroll
                    for (int m = 0; m < 4; ++m) acc[ai][bj][m][n] += bv; }
        f32x4 pre[4][2][2];
#pragma unroll
        for (int m = 0; m < 4; ++m) { const size_t off = (size_t)(u.pm * BM + wr * 64 + m * 16 + fr) * ldc + col0;
#pragma unroll
            for (int bj = 0; bj < 2; ++bj)
#pragma unroll
                for (int n = 0; n < 2; ++n) pre[m][bj][n] = *(const f32x4*)(base + off + bj * HALF + n * 16); }
        const bool bad = st.run(acc, u, wr, wc, fr, fq, lds, wid, lane) || poison != 0u;
        const float qnan = __builtin_nanf("");
#pragma unroll
        for (int ai = 0; ai < 2; ++ai)
#pragma unroll
            for (int m = 0; m < 4; ++m) { const int r = ai * HALF + wr * 64 + m * 16 + fr; const f32x2v sr = S[r]; const size_t off = (size_t)(u.pm * BM + r) * ldc + col0;
#pragma unroll
                for (int bj = 0; bj < 2; ++bj)
#pragma unroll
                    for (int n = 0; n < 2; ++n) { const f32x4 bs = ai == 0 ? pre[m][bj][n] : *(const f32x4*)(base + off + bj * HALF + n * 16); f32x4 o = bs + (acc[ai][bj][m][n] - sr.x) * sr.y;
                        if (bad) o = (f32x4){qnan, qnan, qnan, qnan}; *(f32x4*)(out + off + bj * HALF + n * 16) = o; }
                if (m & 1) asm volatile("" ::: "memory"); }
    }
};
struct EpiLnResLn {
    static constexpr bool PERM = false, AFTER_DRAIN = true;
    const float* base; float* out; bf16_t* xn; int ldc; const float* bias; PanelStats st1, st2; unsigned poison;
    __device__ __forceinline__ void fused(f32x4 (&acc)[2][2][4][2], const Unit& u, int wr, int wc, int fr, int fq, PG8_LAS unsigned char* lds, int wid, int lane) const {
        typedef float f32x2v __attribute__((ext_vector_type(2))); typedef unsigned u32x2v __attribute__((ext_vector_type(2)));
        const PG8_LAS f32x2v* S = (const PG8_LAS f32x2v*)(lds + 8192);
        const int col0 = u.pn * BM + wc * 32 + 4 * fq;
#pragma unroll
        for (int bj = 0; bj < 2; ++bj)
#pragma unroll
            for (int n = 0; n < 2; ++n) { const f32x4 bv = bias ? *(const f32x4*)(bias + col0 + bj * HALF + n * 16) : (f32x4){0.f, 0.f, 0.f, 0.f};
#pragma unroll
                for (int ai = 0; ai < 2; ++ai)
#pragma unroll
                    for (int m = 0; m < 4; ++m) acc[ai][bj][m][n] += bv; }
        bool bad = st1.run(acc, u, wr, wc, fr, fq, lds, wid, lane) || poison != 0u;
        const float qnan = __builtin_nanf("");
#pragma unroll
        for (int ai = 0; ai < 2; ++ai)
#pragma unroll
            for (int m = 0; m < 4; ++m) { const int r = ai * HALF + wr * 64 + m * 16 + fr; const f32x2v sr = S[r]; const size_t off = (size_t)(u.pm * BM + r) * ldc + col0;
#pragma unroll
                for (int bj = 0; bj < 2; ++bj)
#pragma unroll
                    for (int n = 0; n < 2; ++n) { const f32x4 bs = *(const f32x4*)(base + off + bj * HALF + n * 16); acc[ai][bj][m][n] = bs + (acc[ai][bj][m][n] - sr.x) * sr.y; }
                asm volatile("" : "+v"(acc[ai][0][m][0]), "+v"(acc[ai][0][m][1]), "+v"(acc[ai][1][m][0]), "+v"(acc[ai][1][m][1]));
                if (m & 1) asm volatile("" ::: "memory"); }
        const bool bad1 = bad;
        bad = st2.run(acc, u, wr, wc, fr, fq, lds, wid, lane) || bad;
#pragma unroll
        for (int ai = 0; ai < 2; ++ai)
#pragma unroll
            for (int m = 0; m < 4; ++m) { const int r = ai * HALF + wr * 64 + m * 16 + fr; const f32x2v sr = S[r]; const size_t off = (size_t)(u.pm * BM + r) * ldc + col0;
#pragma unroll
                for (int bj = 0; bj < 2; ++bj)
#pragma unroll
                    for (int n = 0; n < 2; ++n) { const f32x4 x1 = acc[ai][bj][m][n]; *(f32x4*)(out + off + bj * HALF + n * 16) = bad1 ? (f32x4){qnan, qnan, qnan, qnan} : x1;
                        const f32x4 o = (x1 - sr.x) * sr.y; u32x2v w; w.x = cvt_pk_bf16(o[0], o[1]); w.y = cvt_pk_bf16(o[2], o[3]);
                        if (bad) { w.x = 0x7fc07fc0u; w.y = 0x7fc07fc0u; } *(u32x2v*)(xn + off + bj * HALF + n * 16) = w; }
                asm volatile("" ::: "memory"); }
    }
};

template <class Epi, class Sched, bool ALIGN_EPI = false, bool SP2 = false>
__device__ __forceinline__ void gemm_phase(PG8_LAS unsigned char* lds, const Gemm g, const Sched& S, const Epi& E) {
    int tid_ = threadIdx.x; asm volatile("" : "+v"(tid_));
    const int tid = tid_, wid = __builtin_amdgcn_readfirstlane(tid >> 6), lane = tid & 63, wr = wid >> 2, wc = wid & 3, fr = lane & 15, fq = lane >> 4;
    const int K = g.K, nt = K / BK;
    unsigned voffA[2], voffB[2];
#pragma unroll
    for (int i = 0; i < 2; ++i) { int R, C; stage_rc(tid * 16 + i * 8192, R, C); const int Rb = Epi::PERM ? ((R & ~31) + perm32(R & 31)) : R;
        voffA[i] = (unsigned)(R * K + C) * 2u; voffB[i] = (unsigned)(Rb * K + C) * 2u; }
    const size_t kstep = (size_t)(BK * 2);
    const size_t hstep = (size_t)HALF * K * 2;
    const size_t tstep = 2 * hstep;
    const unsigned ldsw = (unsigned)wid * 1024u;
    const int aoff = lds_byte(wr * 64 + fr, fq * 8), boff = lds_byte(wc * 32 + fr, fq * 8);
#define PG8_SA(b, h) (((b) * 2 + (h)) * HTB)
#define PG8_SB(b, h) ((4 + (b) * 2 + (h)) * HTB)
#define PG8_STAGE(bufoff, gbase, voff) do { _Pragma("unroll") for (int _i = 0; _i < 2; ++_i) \
        __builtin_amdgcn_global_load_lds((const unsigned*)((const char*)(gbase) + (voff)[_i]), (PG8_LAS unsigned*)(lds + (bufoff) + ldsw + _i * 8192), 16, 0, 0); } while (0)
#define PG8_LDA(dst, b, h) do { _Pragma("unroll") for (int m = 0; m < 4; ++m) _Pragma("unroll") for (int k = 0; k < 2; ++k) dst[m][k] = *(const PG8_LAS bf16x8*)(lds + PG8_SA(b, h) + aoff + m * 2048 + k * 1024); } while (0)
#define PG8_LDB(dst, b, h) do { _Pragma("unroll") for (int n = 0; n < 2; ++n) _Pragma("unroll") for (int k = 0; k < 2; ++k) dst[n][k] = *(const PG8_LAS bf16x8*)(lds + PG8_SB(b, h) + boff + n * 2048 + k * 1024); } while (0)
#define PG8_MMA(ai, bj, At, Bt) do { __builtin_amdgcn_s_setprio(1); _Pragma("unroll") for (int m = 0; m < 4; ++m) _Pragma("unroll") for (int n = 0; n < 2; ++n) _Pragma("unroll") for (int k = 0; k < 2; ++k) \
        acc[ai][bj][m][n] = __builtin_amdgcn_mfma_f32_16x16x32_bf16(Bt[n][k], At[m][k], acc[ai][bj][m][n], 0, 0, 0); __builtin_amdgcn_s_setprio(0); } while (0)
#define PG8_WAIT_V(n) asm volatile("s_waitcnt vmcnt(" #n ")" ::: "memory")
#define PG8_WAIT_L(n) asm volatile("s_waitcnt lgkmcnt(" #n ")" ::: "memory")
#define PG8_BAR __builtin_amdgcn_s_barrier()
#define PG8_SCHED __builtin_amdgcn_sched_barrier(0)
    Unit cur, nxt; int ui = 0;
    if (!S.next(0, cur)) return;
    f32x4 acc[2][2][4][2];
#pragma unroll
    for (int a = 0; a < 2; ++a)
#pragma unroll
        for (int b = 0; b < 2; ++b)
#pragma unroll
            for (int m = 0; m < 4; ++m)
#pragma unroll
                for (int n = 0; n < 2; ++n) acc[a][b][m][n] = (f32x4){0.f, 0.f, 0.f, 0.f};
    bf16x8 At[4][2], B0[2][2], B1[2][2];
    const char* cA = (const char*)g.A + (size_t)cur.pm * tstep; const char* cB = (const char*)g.Bt + (size_t)cur.pn * tstep;
    S.a_ready(cur);
    if constexpr (SP2) {
        PG8_STAGE(PG8_SB(0, 0), cB, voffB); PG8_STAGE(PG8_SB(0, 1), cB + hstep, voffB); PG8_STAGE(PG8_SA(0, 0), cA, voffA); PG8_STAGE(PG8_SA(0, 1), cA + hstep, voffA);
        if (wr == 1) PG8_BAR;
        PG8_WAIT_V(2); PG8_BAR;
        PG8_STAGE(PG8_SB(1, 0), cB + kstep, voffB); PG8_STAGE(PG8_SA(1, 0), cA + kstep, voffA); PG8_STAGE(PG8_SB(1, 1), cB + hstep + kstep, voffB);
        PG8_WAIT_V(6); PG8_BAR;
    } else {
        PG8_STAGE(PG8_SB(0, 0), cB, voffB); PG8_STAGE(PG8_SA(0, 0), cA, voffA); PG8_STAGE(PG8_SB(0, 1), cB + hstep, voffB); PG8_STAGE(PG8_SA(0, 1), cA + hstep, voffA);
        if (wr == 1) PG8_BAR;
        PG8_WAIT_V(4); PG8_BAR;
        PG8_STAGE(PG8_SB(1, 0), cB + kstep, voffB); PG8_STAGE(PG8_SA(1, 0), cA + kstep, voffA); PG8_STAGE(PG8_SB(1, 1), cB + hstep + kstep, voffB);
        PG8_WAIT_V(6); PG8_BAR;
    }
    for (;;) {
        const bool has_next = S.next(ui + 1, nxt);
        const char* nA = has_next ? (const char*)g.A + (size_t)nxt.pm * tstep : cA; const char* nB = has_next ? (const char*)g.Bt + (size_t)nxt.pn * tstep : cB;
        for (int t = 0; t < nt; t += 2) {
            const bool last = (t == nt - 2);
            const char* a1 = cA + (size_t)(t + 1) * kstep;
            const char* a2 = last ? nA : cA + (size_t)(t + 2) * kstep; const char* b2 = last ? nB : cB + (size_t)(t + 2) * kstep;
            const char* a3 = a2 + kstep; const char* b3 = b2 + kstep;
            if (last && has_next) S.a_ready(nxt);
            if constexpr (SP2) {
            PG8_LDB(B0, 0, 0); PG8_LDB(B1, 0, 1); PG8_SCHED; PG8_LDA(At, 0, 0); PG8_STAGE(PG8_SA(1, 1), a1 + hstep, voffA);
            PG8_WAIT_V(8); PG8_WAIT_L(0); PG8_BAR; PG8_MMA(0, 0, At, B0); PG8_MMA(0, 1, At, B1); PG8_BAR; PG8_SCHED;
            PG8_LDA(At, 0, 1); PG8_STAGE(PG8_SB(0, 0), b2, voffB); PG8_STAGE(PG8_SB(0, 1), b2 + hstep, voffB); PG8_STAGE(PG8_SA(0, 0), a2, voffA);
            PG8_WAIT_V(8); PG8_WAIT_L(0); PG8_BAR; PG8_MMA(1, 0, At, B0); PG8_MMA(1, 1, At, B1); PG8_BAR; PG8_SCHED;
            PG8_LDB(B0, 1, 0); PG8_LDB(B1, 1, 1); PG8_SCHED; PG8_LDA(At, 1, 0); PG8_STAGE(PG8_SA(0, 1), a2 + hstep, voffA);
            PG8_WAIT_V(8); PG8_WAIT_L(0); PG8_BAR; PG8_MMA(0, 0, At, B0); PG8_MMA(0, 1, At, B1); PG8_BAR; PG8_SCHED;
            PG8_LDA(At, 1, 1); PG8_STAGE(PG8_SB(1, 0), b3, voffB); PG8_STAGE(PG8_SB(1, 1), b3 + hstep, voffB); PG8_STAGE(PG8_SA(1, 0), a3, voffA);
            PG8_WAIT_V(8); PG8_WAIT_L(0); PG8_BAR; PG8_MMA(1, 0, At, B0); PG8_MMA(1, 1, At, B1); PG8_BAR; PG8_SCHED;
            } else {
            PG8_LDB(B0, 0, 0); PG8_SCHED; PG8_LDA(At, 0, 0); PG8_STAGE(PG8_SA(1, 1), a1 + hstep, voffA);
            PG8_WAIT_L(8); PG8_BAR; PG8_WAIT_L(0); PG8_MMA(0, 0, At, B0); PG8_BAR; PG8_SCHED;
            PG8_LDB(B1, 0, 1); PG8_STAGE(PG8_SB(0, 0), b2, voffB);
            PG8_BAR; PG8_WAIT_L(0); PG8_MMA(0, 1, At, B1); PG8_BAR;
            PG8_LDA(At, 0, 1); PG8_STAGE(PG8_SA(0, 0), a2, voffA);
            PG8_BAR; PG8_WAIT_L(0); PG8_MMA(1, 0, At, B0); PG8_BAR; PG8_SCHED;
            PG8_STAGE(PG8_SB(0, 1), b2 + hstep, voffB);
            PG8_WAIT_V(6); PG8_BAR; PG8_MMA(1, 1, At, B1); PG8_BAR;
            PG8_LDB(B0, 1, 0); PG8_SCHED; PG8_LDA(At, 1, 0); PG8_STAGE(PG8_SA(0, 1), a2 + hstep, voffA);
            PG8_WAIT_L(8); PG8_BAR; PG8_WAIT_L(0); PG8_MMA(0, 0, At, B0); PG8_BAR; PG8_SCHED;
            PG8_LDB(B1, 1, 1); PG8_STAGE(PG8_SB(1, 0), b3, voffB);
            PG8_BAR; PG8_WAIT_L(0); PG8_MMA(0, 1, At, B1); PG8_BAR;
            PG8_LDA(At, 1, 1); PG8_STAGE(PG8_SA(1, 0), a3, voffA);
            PG8_BAR; PG8_WAIT_L(0); PG8_MMA(1, 0, At, B0); PG8_BAR; PG8_SCHED;
            PG8_STAGE(PG8_SB(1, 1), b3 + hstep, voffB);
            PG8_WAIT_V(6); PG8_BAR; PG8_MMA(1, 1, At, B1); PG8_BAR;
            }
        }
        if constexpr (ALIGN_EPI) { if (wr == 0) PG8_BAR; }
        if constexpr (!Epi::AFTER_DRAIN) { E(acc, cur, wr, wc, fr, fq); S.done(cur); }
        if (!has_next) break;
#pragma unroll
        for (int a = 0; a < 2; ++a)
#pragma unroll
            for (int b = 0; b < 2; ++b)
#pragma unroll
                for (int m = 0; m < 4; ++m)
#pragma unroll
                    for (int n = 0; n < 2; ++n) acc[a][b][m][n] = (f32x4){0.f, 0.f, 0.f, 0.f};
        cur = nxt; cA = nA; cB = nB; ++ui;
        if constexpr (ALIGN_EPI) { if (wr == 1) PG8_BAR; }
    }
    PG8_WAIT_V(0);
    if constexpr (!ALIGN_EPI) { if (wr == 0) PG8_BAR; }
    PG8_BAR;
    if constexpr (Epi::AFTER_DRAIN) { E.fused(acc, cur, wr, wc, fr, fq, lds, wid, lane); S.done(cur); }
#undef PG8_SA
#undef PG8_SB
#undef PG8_STAGE
#undef PG8_LDA
#undef PG8_LDB
#undef PG8_MMA
#undef PG8_WAIT_V
#undef PG8_WAIT_L
#undef PG8_BAR
#undef PG8_SCHED
}
}
namespace pg8 {
struct EpiF32 {
    static constexpr bool PERM = false, AFTER_DRAIN = false;
    float* C; int ldc;
    __device__ __forceinline__ void operator()(const f32x4 (&acc)[2][2][4][2], const Unit& u, int wr, int wc, int fr, int fq) const {
        const int row0 = u.pm * BM + wr * 64 + fr, col0 = u.pn * BM + wc * 32 + 4 * fq;
#pragma unroll
        for (int ai = 0; ai < 2; ++ai)
#pragma unroll
            for (int m = 0; m < 4; ++m) { float* rowp = C + (size_t)(row0 + ai * HALF + m * 16) * ldc + col0;
#pragma unroll
                for (int bj = 0; bj < 2; ++bj)
#pragma unroll
                    for (int n = 0; n < 2; ++n) *(f32x4*)(rowp + bj * HALF + n * 16) = acc[ai][bj][m][n]; }
    }
};
}
#ifndef PG8_SP2
#define PG8_SP2 true
#endif
#ifndef PG8_ALIGN
#define PG8_ALIGN true
#endif
#endif
constexpr int BATCH = 4, SEQ = 2048, DM = 2048, DEPTH = 2;
constexpr int MTOK = BATCH * SEQ;
constexpr int DBR = 512;
constexpr int D_IN = 6016, LDP = 6144;
constexpr int CA_R = 0, CA_K = 512, CA_V = 1024, CA_WD = 1536, CA_AD = 1600, A_COLS = 1664;
constexpr int CB_Q = 1664, CB_K = 2176, CB_V = 2304;
constexpr int CC_Z = 2432;
constexpr int CD_U = 2944, CD_V = 3456;
constexpr int CG = 3968;
constexpr float NORM_EPS = 1e-6f, LN_EPS = 1e-5f, GN_EPS = 64e-5f;

typedef unsigned short bf16;
#define HD __host__ __device__ __forceinline__
HD float bf2f(bf16 v) { return __builtin_bit_cast(float, ((unsigned)v) << 16); }
HD bf16 f2bf(float f) { unsigned u = __builtin_bit_cast(unsigned, f); return (bf16)((u + 0x7fffu + ((u >> 16) & 1u)) >> 16); }
HD float silu_f(float g) { return g / (1.f + expf(-g)); }
HD float gelu_f(float x) { return 0.5f * x * (1.f + erff(x * 0.70710678118654752f)); }
HD float sigmoid_f(float x) { return 1.f / (1.f + expf(-x)); }
HD float softplus_f(float x) { return x > 20.f ? x : log1pf(expf(x)); }

struct NP {
    int B, T;
    const bf16* proj;
    bf16* Y;
    float *TW, *R, *W, *K2, *V, *A, *Bv, *YR, *POOLED, *VN;
    const float *mu, *w0, *w_up, *a0, *a_up, *k_k, *k_a, *r_k, *ln_w, *ln_b, *sinks, *pool_w, *pool_scale, *sgu_norm_w, *sgu_w, *sgu_b;
};
HD float pj(const NP& p, int m, int col) { return bf2f(p.proj[(size_t)m * LDP + col]); }
HD float zshift(const NP& p, int m, int t, int col) { const float z = pj(p, m, col); const float zp = t > 0 ? pj(p, m - 1, col) : 0.f; return z + p.mu[col] * (zp - z); }

HD void n_tw(const NP& p, int item) {
    const int m = item >> 7, j = item & 127, t = m % p.T;
    const float z = zshift(p, m, t, CA_WD + j);
    p.TW[item] = j < 64 ? tanhf(z) : z;
}
HD void n_pool_pre(const NP& p, int item) {
    const int m = item >> 9, c = item & 511, g = c >> 7, t = m % p.T, w = 2 << g;
    const int cnt = (t + 1) < w ? (t + 1) : w;
    float s = 0.f;
    for (int q = 0; q < cnt; ++q) s += pj(p, m - q, CC_Z + c);
    p.POOLED[item] = s / (float)cnt - pj(p, m, CC_Z + c);
}
HD void n_sgu_pre(const NP& p, int m) {
    float s = 0.f, ss = 0.f;
    for (int c = 0; c < DBR; ++c) { const float g = gelu_f(pj(p, m, CD_V + c)); s += g; ss += g * g; p.VN[(size_t)m * DBR + c] = g; }
    const float mean = s * (1.f / DBR); float var = ss * (1.f / DBR) - mean * mean; var = var < 0.f ? 0.f : var;
    const float rstd = 1.f / sqrtf(var + LN_EPS);
    for (int c = 0; c < DBR; ++c) { const size_t i = (size_t)m * DBR + c; p.VN[i] = (p.VN[i] - mean) * rstd * p.sgu_norm_w[c]; }
}
HD void n_rwkv_prep(const NP& p, int item) {
    const int m = item >> 9, c = item & 511, t = m % p.T;
    const float r = zshift(p, m, t, CA_R + c), k = zshift(p, m, t, CA_K + c), v = zshift(p, m, t, CA_V + c);
    float wl = p.w0[c], al = p.a0[c];
    const float* tw = p.TW + (size_t)m * 128;
    for (int j = 0; j < 64; ++j) { wl += tw[j] * p.w_up[j * DBR + c]; al += tw[64 + j] * p.a_up[j * DBR + c]; }
    const float w_log = -softplus_f(-wl) - 0.5f;
    const float decay = expf(-expf(w_log));
    const float a = sigmoid_f(al);
    p.R[item] = r; p.W[item] = decay; p.V[item] = v;
    p.K2[item] = k * (1.f + (a - 1.f) * p.k_a[c]);
    p.A[item] = k * p.k_k[c];
    p.Bv[item] = a;
}
HD void n_rwkv_fin(const NP& p, int item) {
    const size_t base = (size_t)item * 64;
    float ss = 0.f;
    for (int j = 0; j < 64; ++j) { const float x = p.A[base + j]; ss += x * x; }
    const float nrm = sqrtf(ss), inv = 1.f / (nrm > 1e-12f ? nrm : 1e-12f);
    for (int j = 0; j < 64; ++j) { const float kk = p.A[base + j] * inv, a = p.Bv[base + j]; p.A[base + j] = -kk; p.Bv[base + j] = kk * a; }
}
HD void n_rwkv_scan(const NP& p, int item) {
    const int bh = item >> 6, i = item & 63, b = bh >> 3, h = bh & 7;
    float S[64];
#pragma unroll
    for (int j = 0; j < 64; ++j) S[j] = 0.f;
    for (int t = 0; t < p.T; ++t) {
        const size_t base = ((size_t)(b * p.T + t)) * DBR + h * 64;
        const float* A = p.A + base; const float* Bv = p.Bv + base; const float* W = p.W + base; const float* K2 = p.K2 + base; const float* R = p.R + base;
        const float v = p.V[base + i];
        float sa = 0.f;
#pragma unroll
        for (int j = 0; j < 64; ++j) sa += S[j] * A[j];
        float y = 0.f;
#pragma unroll
        for (int j = 0; j < 64; ++j) { S[j] = S[j] * W[j] + sa * Bv[j] + v * K2[j]; y += S[j] * R[j]; }
        p.YR[base + i] = y;
    }
}
HD void n_rwkv_post(const NP& p, int item) {
    const int m = item >> 3, h = item & 7; const size_t base = (size_t)m * DBR + h * 64;
    float s = 0.f, rk = 0.f;
    for (int c = 0; c < 64; ++c) { s += p.YR[base + c]; rk += p.R[base + c] * p.K2[base + c] * p.r_k[h * 64 + c]; }
    const float mean = s * (1.f / 64.f); float q = 0.f;
    for (int c = 0; c < 64; ++c) { const float d = p.YR[base + c] - mean; q += d * d; }
    const float rstd = 1.f / sqrtf(q * (1.f / 64.f) + GN_EPS);
    for (int c = 0; c < 64; ++c) {
        const int ch = h * 64 + c;
        const float o = (p.YR[base + c] - mean) * rstd * p.ln_w[ch] + p.ln_b[ch] + rk * p.V[base + c];
        p.Y[(size_t)m * DM + ch] = f2bf(o * silu_f(pj(p, m, CG + ch)));
    }
}
HD void n_swa(const NP& p, int item) {
    const int m = item >> 3, h = item & 7, kvh = h >> 2, t = m % p.T;
    const float slope = exp2f(-(float)(h + 1));
    float q[64];
#pragma unroll
    for (int d = 0; d < 64; ++d) q[d] = pj(p, m, CB_Q + h * 64 + d) * 0.125f;
    const int nk = t < 127 ? t + 1 : 128;
    float mx = p.sinks[h];
    for (int dist = 0; dist < nk; ++dist) {
        const bf16* kr = p.proj + (size_t)(m - dist) * LDP + CB_K + kvh * 64;
        float s = 0.f;
#pragma unroll
        for (int d = 0; d < 64; ++d) s += q[d] * bf2f(kr[d]);
        s -= slope * (float)dist;
        mx = s > mx ? s : mx;
    }
    float o[64];
#pragma unroll
    for (int d = 0; d < 64; ++d) o[d] = 0.f;
    float den = expf(p.sinks[h] - mx);
    for (int dist = 0; dist < nk; ++dist) {
        const bf16* kr = p.proj + (size_t)(m - dist) * LDP + CB_K + kvh * 64;
        const bf16* vr = p.proj + (size_t)(m - dist) * LDP + CB_V + kvh * 64;
        float s = 0.f;
#pragma unroll
        for (int d = 0; d < 64; ++d) s += q[d] * bf2f(kr[d]);
        s -= slope * (float)dist;
        const float pr = expf(s - mx); den += pr;
#pragma unroll
        for (int d = 0; d < 64; ++d) o[d] += pr * bf2f(vr[d]);
    }
    const float inv = 1.f / den;
#pragma unroll
    for (int d = 0; d < 64; ++d) { const int ch = DBR + h * 64 + d; p.Y[(size_t)m * DM + ch] = f2bf(o[d] * inv * silu_f(pj(p, m, CG + ch))); }
}
HD void n_pool_out(const NP& p, int item) {
    const int m = item >> 9, c = item & 511, g = c >> 7, d = c & 127;
    const float* pl = p.POOLED + (size_t)m * DBR + g * 128; const float* w = p.pool_w + (size_t)g * 128 * 128 + d;
    float y = 0.f;
    for (int cc = 0; cc < 128; ++cc) y += pl[cc] * w[cc * 128];
    y *= p.pool_scale[c];
    const int ch = 2 * DBR + c;
    p.Y[(size_t)m * DM + ch] = f2bf(y * silu_f(pj(p, m, CG + ch)));
}
HD void n_sgu_out(const NP& p, int item) {
    const int m = item >> 9, c = item & 511, g = c >> 7, t = m % p.T, i = t & 127, m0 = m - i;
    const float* wrow = p.sgu_w + ((size_t)g * 128 + i) * 128;
    float s = p.sgu_b[g * 128 + i];
    for (int j = 0; j <= i; ++j) s += wrow[j] * p.VN[(size_t)(m0 + j) * DBR + c];
    const float u = gelu_f(pj(p, m, CD_U + c));
    const int ch = 3 * DBR + c;
    p.Y[(size_t)m * DM + ch] = f2bf(u * s * silu_f(pj(p, m, CG + ch)));
}
typedef short bf16x8 __attribute__((ext_vector_type(8)));
typedef short bf16x4 __attribute__((ext_vector_type(4)));
typedef float f32x16 __attribute__((ext_vector_type(16)));
typedef unsigned u32x4 __attribute__((ext_vector_type(4)));
typedef unsigned u32x2 __attribute__((ext_vector_type(2)));
typedef float f32x4v __attribute__((ext_vector_type(4)));
#ifdef HOST_TEST
#define LQ
#define MXD inline
int emu_tid(); void emu_sync(); f32x16 emu_mfma32(bf16x8 a, bf16x8 b, f32x16 c); float emu_shfl_xor(float v, int mask);
#define M_TID emu_tid()
#define M_SYNC() emu_sync()
#define M_MFMA32(a, b, c) emu_mfma32(a, b, c)
#define M_SHFL_XOR(v, m) emu_shfl_xor(v, m)
#else
#define LQ __attribute__((address_space(3)))
#define MXD __device__ __forceinline__
__device__ __forceinline__ int m_opaque_tid() { int t = threadIdx.x; asm volatile("" : "+v"(t)); return t; }
#define M_TID m_opaque_tid()
#define M_SYNC() __syncthreads()
#define M_MFMA32(a, b, c) __builtin_amdgcn_mfma_f32_32x32x16_bf16(a, b, c, 0, 0, 0)
#define M_SHFL_XOR(v, m) __shfl_xor(v, m)
#endif
typedef LQ unsigned char* ldsp_t;
typedef LQ bf16* ldsb_t;

struct MixP {
    const bf16* proj;
    bf16* Y;
    const bf16 *poolWT, *sguWB;
    const float *pool_scale, *sgu_norm_w, *sgu_b, *sinks;
};
MXD unsigned pack2(float lo, float hi) { return (unsigned)f2bf(lo) | ((unsigned)f2bf(hi) << 16); }
MXD int acc_row(int e, int h) { return (e & 3) + 8 * (e >> 2) + 4 * h; }
MXD void mm_tile(f32x16& acc, const LQ bf16* A, int lda, const LQ bf16* Bt, int ldb, int K, int lane) {
    const int r = lane & 31, h = lane >> 5;
    const LQ bf16* ap = A + r * lda + 8 * h; const LQ bf16* bp = Bt + r * ldb + 8 * h;
    for (int k = 0; k < K; k += 16) { const bf16x8 a = *(const LQ bf16x8*)(ap + k); const bf16x8 b = *(const LQ bf16x8*)(bp + k); acc = M_MFMA32(a, b, acc); }
}
MXD f32x16 zero16() { f32x16 z; for (int e = 0; e < 16; ++e) z[e] = 0.f; return z; }

MXD void pool_unit(ldsp_t lds, const MixP& p, int unit) {
    const int tid = M_TID, lane = tid & 63, wave = tid >> 6;
    const int b = unit >> 6, n = (unit >> 2) & 15, g = unit & 3, w = 2 << g;
    const int m0 = b * SEQ + n * 128;
    ldsb_t Z = (ldsb_t)lds; ldsb_t P = (ldsb_t)(lds + 36864); ldsb_t W = (ldsb_t)(lds + 71680);
    for (int i = tid; i < 144 * 16; i += 512) {
        const int row = i >> 4, ch = i & 15, t = n * 128 + row - 16;
        u32x4 v = (u32x4){0u, 0u, 0u, 0u};
        if (t >= 0) v = *(const u32x4*)(p.proj + (size_t)(m0 + row - 16) * LDP + CC_Z + g * 128 + ch * 8);
        *(LQ u32x4*)(Z + row * 128 + ch * 8) = v;
    }
    for (int i = tid; i < 128 * 16; i += 512) {
        const int row = i >> 4, ch = i & 15;
        *(LQ u32x4*)(W + row * 136 + ch * 8) = *(const u32x4*)(p.poolWT + ((size_t)g * 128 + row) * 128 + ch * 8);
    }
    M_SYNC();
    {
        const int c = tid & 127, tq = tid >> 7, tb = 32 * tq;
        float s = 0.f;
        for (int q = 1; q < w; ++q) s += bf2f(Z[(16 + tb - q) * 128 + c]);
        for (int t = tb; t < tb + 32; ++t) {
            const float zt = bf2f(Z[(16 + t) * 128 + c]);
            s += zt;
            const int tpos = n * 128 + t, cnt = (tpos + 1) < w ? (tpos + 1) : w;
            P[t * 136 + c] = f2bf(s / (float)cnt - zt);
            s -= bf2f(Z[(16 + t - (w - 1)) * 128 + c]);
        }
    }
    M_SYNC();
    const int tr = wave & 3, tc0 = 2 * (wave >> 2);
    f32x16 acc[2] = {zero16(), zero16()};
    for (int j = 0; j < 2; ++j) mm_tile(acc[j], P + 32 * tr * 136, 136, W + 32 * (tc0 + j) * 136, 136, 128, lane);
    const int h = lane >> 5, col = lane & 31;
    for (int j = 0; j < 2; ++j) {
        const int d = 32 * (tc0 + j) + col; const float sc = p.pool_scale[g * 128 + d];
        for (int e = 0; e < 16; ++e) {
            const int t = 32 * tr + acc_row(e, h); const int ch = 2 * DBR + g * 128 + d; const size_t m = (size_t)(m0 + t);
            const float gate = bf2f(p.proj[m * LDP + CG + ch]);
            p.Y[m * DM + ch] = f2bf(acc[j][e] * sc * silu_f(gate));
        }
    }
    M_SYNC();
}

MXD void sgu_unit(ldsp_t lds, const MixP& p, int unit) {
    const int tid = M_TID, lane = tid & 63, wave = tid >> 6;
    const int b = unit >> 6, n = (unit >> 2) & 15, g = unit & 3;
    const int m0 = b * SEQ + n * 128;
    ldsb_t WS = (ldsb_t)lds; ldsb_t VT = (ldsb_t)(lds + 34816); LQ float* ST = (LQ float*)(lds + 69632);
    for (int i = tid; i < 128 * 16; i += 512) { const int row = i >> 4, ch = i & 15;
        *(LQ u32x4*)(WS + row * 136 + ch * 8) = *(const u32x4*)(p.sguWB + ((size_t)g * 128 + row) * 128 + ch * 8); }
    for (int tt = 0; tt < 16; ++tt) {
        const int t = 16 * wave + tt;
        const bf16x8 v = *(const bf16x8*)(p.proj + (size_t)(m0 + t) * LDP + CD_V + 8 * lane);
        float s = 0.f, ss = 0.f;
        for (int e = 0; e < 8; ++e) { const float x = gelu_f(bf2f((bf16)v[e])); s += x; ss += x * x; }
        for (int o = 1; o < 64; o <<= 1) { s += M_SHFL_XOR(s, o); ss += M_SHFL_XOR(ss, o); }
        const float mean = s * (1.f / DBR); float var = ss * (1.f / DBR) - mean * mean; var = var < 0.f ? 0.f : var;
        if (lane == 0) { ST[2 * t] = mean; ST[2 * t + 1] = 1.f / sqrtf(var + LN_EPS); }
    }
    M_SYNC();
    for (int i = tid; i < 128 * 16; i += 512) {
        const int ch = i >> 7, j = i & 127;
        const bf16x8 v = *(const bf16x8*)(p.proj + (size_t)(m0 + j) * LDP + CD_V + g * 128 + ch * 8);
        const float mean = ST[2 * j], rstd = ST[2 * j + 1];
        for (int e = 0; e < 8; ++e) { const int d = ch * 8 + e; VT[d * 136 + j] = f2bf((gelu_f(bf2f((bf16)v[e])) - mean) * rstd * p.sgu_norm_w[g * 128 + d]); }
    }
    M_SYNC();
    const int tr = wave & 3, tc0 = 2 * (wave >> 2);
    f32x16 acc[2] = {zero16(), zero16()};
    for (int j = 0; j < 2; ++j) mm_tile(acc[j], WS + 32 * tr * 136, 136, VT + 32 * (tc0 + j) * 136, 136, 32 * (tr + 1), lane);
    const int h = lane >> 5, col = lane & 31;
    for (int j = 0; j < 2; ++j) {
        const int d = 32 * (tc0 + j) + col;
        for (int e = 0; e < 16; ++e) {
            const int i = 32 * tr + acc_row(e, h); const int ch = 3 * DBR + g * 128 + d; const size_t m = (size_t)(m0 + i);
            const float s = acc[j][e] + p.sgu_b[g * 128 + i];
            const float u = gelu_f(bf2f(p.proj[m * LDP + CD_U + g * 128 + d]));
            p.Y[m * DM + ch] = f2bf(u * s * silu_f(bf2f(p.proj[m * LDP + CG + ch])));
        }
    }
    M_SYNC();
}

MXD void swa_unit(ldsp_t lds, const MixP& p, int unit) {
    const int tid = M_TID, lane = tid & 63, wave = tid >> 6;
    const int qhalf = unit & 1, kvh = (unit >> 1) & 1, n = (unit >> 2) & 15, b = unit >> 6;
    const int m0 = b * SEQ + n * 128, qbase = 64 * qhalf;
    ldsb_t KS = (ldsb_t)lds; ldsb_t VT = (ldsb_t)(lds + 27648);
    for (int i = tid; i < 192 * 8; i += 512) {
        const int ks = i >> 3, ch = i & 7, s = qbase + ks;
        u32x4 v = (u32x4){0u, 0u, 0u, 0u};
        if (n * 128 + s - 128 >= 0) v = *(const u32x4*)(p.proj + (size_t)(m0 + s - 128) * LDP + CB_K + kvh * 64 + ch * 8);
        *(LQ u32x4*)(KS + ks * 72 + ch * 8) = v;
    }
    for (int i = tid; i < 192 * 8; i += 512) {
        const int ch = i / 192, ks = i % 192, s = qbase + ks;
        bf16x8 v = (bf16x8){0, 0, 0, 0, 0, 0, 0, 0};
        if (n * 128 + s - 128 >= 0) v = *(const bf16x8*)(p.proj + (size_t)(m0 + s - 128) * LDP + CB_V + kvh * 64 + ch * 8);
        for (int e = 0; e < 8; ++e) VT[(ch * 8 + e) * 200 + ks] = (bf16)v[e];
    }
    M_SYNC();
    const int g = wave >> 1, qt = wave & 1, head = kvh * 4 + g, r = lane & 31, h = lane >> 5;
    const float slope = exp2f(-(float)(head + 1)), sink = p.sinks[head];
    const size_t mq = (size_t)(m0 + qbase + 32 * qt + r);
    bf16x8 qf[4];
    for (int kd = 0; kd < 4; ++kd) qf[kd] = *(const bf16x8*)(p.proj + mq * LDP + CB_Q + head * 64 + 16 * kd + 8 * h);
    f32x16 acc[5];
    for (int kt = 0; kt < 5; ++kt) {
        acc[kt] = zero16();
        for (int kd = 0; kd < 4; ++kd) { const bf16x8 a = *(const LQ bf16x8*)(KS + (32 * qt + 32 * kt + r) * 72 + 16 * kd + 8 * h); acc[kt] = M_MFMA32(a, qf[kd], acc[kt]); }
    }
    float mx = sink;
    for (int kt = 0; kt < 5; ++kt)
        for (int e = 0; e < 16; ++e) {
            const int row = acc_row(e, h), dist = r + 128 - 32 * kt - row, sidx = qbase + 32 * qt + 32 * kt + row;
            const bool valid = dist >= 0 && dist < 128 && (n > 0 || sidx >= 128);
            const float sc = valid ? acc[kt][e] * 0.125f - slope * (float)dist : -1e30f;
            acc[kt][e] = sc; mx = sc > mx ? sc : mx;
        }
    { const float o = M_SHFL_XOR(mx, 32); mx = o > mx ? o : mx; }
    float lsum = 0.f;
    for (int kt = 0; kt < 5; ++kt)
        for (int e = 0; e < 16; ++e) { const float sc = acc[kt][e]; const float pr = sc > -1e29f ? expf(sc - mx) : 0.f; acc[kt][e] = pr; lsum += pr; }
    lsum += M_SHFL_XOR(lsum, 32);
    lsum += expf(sink - mx);
    f32x16 o[2] = {zero16(), zero16()};
    for (int kt = 0; kt < 5; ++kt)
        for (int s2 = 0; s2 < 2; ++s2) {
            u32x4 pw; pw.x = pack2(acc[kt][8 * s2 + 0], acc[kt][8 * s2 + 1]); pw.y = pack2(acc[kt][8 * s2 + 2], acc[kt][8 * s2 + 3]);
            pw.z = pack2(acc[kt][8 * s2 + 4], acc[kt][8 * s2 + 5]); pw.w = pack2(acc[kt][8 * s2 + 6], acc[kt][8 * s2 + 7]);
            const bf16x8 bfr = __builtin_bit_cast(bf16x8, pw);
            for (int dt = 0; dt < 2; ++dt) {
                const LQ bf16* vp = VT + (32 * dt + r) * 200 + 32 * qt + 32 * kt + 16 * s2 + 4 * h;
                const u32x2 lo = *(const LQ u32x2*)vp, hi = *(const LQ u32x2*)(vp + 8);
                const u32x4 av = (u32x4){lo.x, lo.y, hi.x, hi.y};
                o[dt] = M_MFMA32(__builtin_bit_cast(bf16x8, av), bfr, o[dt]);
            }
        }
    const float inv = 1.f / lsum;
    for (int dt = 0; dt < 2; ++dt)
        for (int q4 = 0; q4 < 4; ++q4) {
            const int d0 = 32 * dt + 8 * q4 + 4 * h, ch = DBR + head * 64 + d0;
            const u32x2 gv = *(const u32x2*)(p.proj + mq * LDP + CG + ch);
            const float g0 = silu_f(bf2f((bf16)(gv.x & 0xffffu))), g1 = silu_f(bf2f((bf16)(gv.x >> 16))), g2 = silu_f(bf2f((bf16)(gv.y & 0xffffu))), g3 = silu_f(bf2f((bf16)(gv.y >> 16)));
            u32x2 ov; ov.x = pack2(o[dt][4 * q4 + 0] * inv * g0, o[dt][4 * q4 + 1] * inv * g1); ov.y = pack2(o[dt][4 * q4 + 2] * inv * g2, o[dt][4 * q4 + 3] * inv * g3);
            *(u32x2*)(p.Y + mq * DM + ch) = ov;
        }
    M_SYNC();
}

struct RwkvP {
    const bf16* proj; bf16* Y;
    const bf16 *WupT, *AupT;
    const float *mu, *w0, *a0, *k_k, *k_a, *r_k, *ln_w, *ln_b;
    unsigned *GTd, *Ed, *Q1Td, *Hd; float *Q2d, *RK;
};
constexpr int RS = 9216;
#define RSLOT(k) ((ldsb_t)(lds + (k) * RS))
MXD void shift8(const bf16* proj, size_t row, bool hasprev, int col, const float* mu, float (&out)[8]) {
    const bf16x8 z = *(const bf16x8*)(proj + row + col);
    bf16x8 zp = (bf16x8){0, 0, 0, 0, 0, 0, 0, 0};
    if (hasprev) zp = *(const bf16x8*)(proj + row - LDP + col);
    for (int e = 0; e < 8; ++e) { const float zf = bf2f((bf16)z[e]), zpf = bf2f((bf16)zp[e]); out[e] = zf + mu[col + e] * (zpf - zf); }
}
MXD void st8_bf16(LQ bf16* dst, const float (&v)[8]) { u32x4 w; w.x = pack2(v[0], v[1]); w.y = pack2(v[2], v[3]); w.z = pack2(v[4], v[5]); w.w = pack2(v[6], v[7]); *(LQ u32x4*)dst = w; }
MXD void st_tile_rm(LQ bf16* dst, int ld, const f32x16& acc, int lane) { const int col = lane & 31, h = lane >> 5; for (int e = 0; e < 16; ++e) dst[acc_row(e, h) * ld + col] = f2bf(acc[e]); }
MXD void st_tile_tr(LQ bf16* dstT, int ld, const f32x16& acc, int lane) {
    const int col = lane & 31, h = lane >> 5;
    for (int q4 = 0; q4 < 4; ++q4) { u32x2 w; w.x = pack2(acc[4 * q4], acc[4 * q4 + 1]); w.y = pack2(acc[4 * q4 + 2], acc[4 * q4 + 3]); *(LQ u32x2*)(dstT + col * ld + 8 * q4 + 4 * h) = w; }
}
MXD void st_tile_f32(LQ float* dst, int ld, const f32x16& acc, int lane) { const int col = lane & 31, h = lane >> 5; for (int e = 0; e < 16; ++e) dst[acc_row(e, h) * ld + col] = acc[e]; }
MXD void dump_bf16(unsigned* g, const f32x16& acc) { u32x4 w0, w1; w0.x = pack2(acc[0], acc[1]); w0.y = pack2(acc[2], acc[3]); w0.z = pack2(acc[4], acc[5]); w0.w = pack2(acc[6], acc[7]);
    w1.x = pack2(acc[8], acc[9]); w1.y = pack2(acc[10], acc[11]); w1.z = pack2(acc[12], acc[13]); w1.w = pack2(acc[14], acc[15]); *(u32x4*)g = w0; *(u32x4*)(g + 4) = w1; }

MXD void rwkv_r1_unit(ldsp_t lds, const RwkvP& p, int unit) {
    const int tid = M_TID, lane = tid & 63, wave = tid >> 6, wq = wave & 3, grp = wave >> 2;
    const int c = unit & 31, h = (unit >> 5) & 7, b = unit >> 8;
    const int m0 = b * SEQ + c * 64;
    const int t = tid >> 3, cg = tid & 7, ch0 = 8 * cg;
    const int tr = wq >> 1, tc = wq & 1, r = lane & 31, hh = lane >> 5;
    LQ float* GC = (LQ float*)(lds + 15 * RS); LQ float* LDG = (LQ float*)(lds + 15 * RS + 256);
    LQ float* F0 = (LQ float*)(lds + 5 * RS); LQ float* F1 = (LQ float*)(lds + 7 * RS); LQ float* F2 = (LQ float*)(lds + 2 * RS);
    float rr[8], kr[8];
    {
        const size_t row = (size_t)(m0 + t) * LDP; const bool hasprev = (c * 64 + t) > 0;
        float x[8];
        shift8(p.proj, row, hasprev, CA_WD + ch0, p.mu, x); for (int e = 0; e < 8; ++e) x[e] = tanhf(x[e]); st8_bf16(RSLOT(0) + t * 72 + ch0, x);
        shift8(p.proj, row, hasprev, CA_AD + ch0, p.mu, x); st8_bf16(RSLOT(1) + t * 72 + ch0, x);
        shift8(p.proj, row, hasprev, CA_V + h * 64 + ch0, p.mu, x); for (int e = 0; e < 8; ++e) RSLOT(4)[(ch0 + e) * 72 + t] = f2bf(x[e]);
        shift8(p.proj, row, hasprev, CA_R + h * 64 + ch0, p.mu, rr);
        shift8(p.proj, row, hasprev, CA_K + h * 64 + ch0, p.mu, kr);
        *(LQ u32x4*)(RSLOT(2) + t * 72 + ch0) = *(const u32x4*)(p.WupT + (size_t)(h * 64 + t) * 64 + ch0);
        *(LQ u32x4*)(RSLOT(3) + t * 72 + ch0) = *(const u32x4*)(p.AupT + (size_t)(h * 64 + t) * 64 + ch0);
    }
    M_SYNC();
    {
        f32x16 acc = zero16();
        mm_tile(acc, RSLOT(grp) + 32 * tr * 72, 72, RSLOT(2 + grp) + 32 * tc * 72, 72, 64, lane);
        st_tile_f32((grp ? F1 : F0) + 32 * tr * 68 + 32 * tc, 68, acc, lane);
    }
    M_SYNC();
    float lw[8], av[8], kkn[8], kp[8];
    {
        float ss = 0.f, rks = 0.f;
        for (int e = 0; e < 8; ++e) {
            const int ch = h * 64 + ch0 + e;
            const float wl = F0[t * 68 + ch0 + e] + p.w0[ch], al = F1[t * 68 + ch0 + e] + p.a0[ch];
            const float w_log = -softplus_f(-wl) - 0.5f;
            lw[e] = -expf(w_log);
            av[e] = sigmoid_f(al);
            kkn[e] = kr[e] * p.k_k[ch]; ss += kkn[e] * kkn[e];
            kp[e] = kr[e] * (1.f + (av[e] - 1.f) * p.k_a[ch]);
            rks += rr[e] * kp[e] * p.r_k[ch];
        }
        for (int o = 1; o < 8; o <<= 1) { ss += M_SHFL_XOR(ss, o); rks += M_SHFL_XOR(rks, o); }
        const float nrm = sqrtf(ss), inv = 1.f / (nrm > 1e-12f ? nrm : 1e-12f);
        for (int e = 0; e < 8; ++e) kkn[e] *= inv;
        if (cg == 0) p.RK[(size_t)(m0 + t) * 8 + h] = rks;
        for (int e = 0; e < 8; ++e) { const bf16 hi = f2bf(lw[e]); const bf16 lo = f2bf(lw[e] - bf2f(hi)); RSLOT(0)[(ch0 + e) * 72 + t] = hi; RSLOT(1)[(ch0 + e) * 72 + t] = lo; }
    }
    M_SYNC();
    if (grp == 0) {
        f32x16 acc = zero16();
        for (int ks = 0; ks < 4; ++ks) {
            bf16x8 a;
            for (int j = 0; j < 8; ++j) a[j] = (16 * ks + 8 * hh + j) <= (32 * tr + r) ? (short)0x3F80 : (short)0;
            const bf16x8 bh = *(const LQ bf16x8*)(RSLOT(0) + (32 * tc + r) * 72 + 16 * ks + 8 * hh), bl = *(const LQ bf16x8*)(RSLOT(1) + (32 * tc + r) * 72 + 16 * ks + 8 * hh);
            acc = M_MFMA32(a, bh, acc); acc = M_MFMA32(a, bl, acc);
        }
        st_tile_f32(F2 + 32 * tr * 68 + 32 * tc, 68, acc, lane);
    }
    M_SYNC();
    {
        float xa[8], xb[8], xk[8], xr[8], xbh[8], xkh[8];
        for (int e = 0; e < 8; ++e) {
            const float lam = F2[t * 68 + ch0 + e], lamC = F2[63 * 68 + ch0 + e];
            const float eg = expf(lam), egm1 = expf(lam - lw[e]), einv = expf(-lam), eC = expf(lamC - lam);
            xa[e] = -kkn[e] * egm1; xb[e] = kkn[e] * av[e] * einv; xk[e] = kp[e] * einv; xr[e] = rr[e] * eg; xbh[e] = kkn[e] * av[e] * eC; xkh[e] = kp[e] * eC;
            if (t == 63) GC[ch0 + e] = expf(lamC);
        }
        st8_bf16(RSLOT(5) + t * 72 + ch0, xa); st8_bf16(RSLOT(6) + t * 72 + ch0, xb); st8_bf16(RSLOT(7) + t * 72 + ch0, xk); st8_bf16(RSLOT(8) + t * 72 + ch0, xr);
        for (int e = 0; e < 8; ++e) { RSLOT(9)[(ch0 + e) * 72 + t] = f2bf(xa[e]); RSLOT(10)[(ch0 + e) * 72 + t] = f2bf(xbh[e]); RSLOT(11)[(ch0 + e) * 72 + t] = f2bf(xkh[e]); }
    }
    M_SYNC();
    {
        f32x16 a0 = zero16(), a1 = zero16();
        mm_tile(a0, RSLOT(grp ? 8 : 5) + 32 * tr * 72, 72, RSLOT(6) + 32 * tc * 72, 72, 64, lane);
        mm_tile(a1, RSLOT(grp ? 8 : 5) + 32 * tr * 72, 72, RSLOT(7) + 32 * tc * 72, 72, 64, lane);
        for (int e = 0; e < 16; ++e) {
            const int tt = 32 * tr + acc_row(e, hh), s = 32 * tc + r;
            if (grp == 0) {
                const float lab = s < tt ? a0[e] : 0.f;
                if ((tt >> 4) == (s >> 4)) LDG[(tt >> 4) * 256 + (tt & 15) * 16 + (s & 15)] = lab;
                RSLOT(0)[tt * 72 + s] = ((tt >> 5) == (s >> 5) && (tt >> 4) != (s >> 4)) ? f2bf(lab) : (bf16)0;
                RSLOT(1)[tt * 72 + s] = ((tt >> 5) != (s >> 5)) ? f2bf(lab) : (bf16)0;
                RSLOT(2)[tt * 72 + s] = s < tt ? f2bf(a1[e]) : (bf16)0;
            } else {
                RSLOT(3)[tt * 72 + s] = s <= tt ? f2bf(a0[e]) : (bf16)0;
                RSLOT(12)[tt * 72 + s] = s <= tt ? f2bf(a1[e]) : (bf16)0;
            }
        }
    }
    M_SYNC();
    if (grp == 1) {
        f32x16 acc = zero16();
        mm_tile(acc, RSLOT(2) + 32 * tr * 72, 72, RSLOT(4) + 32 * tc * 72, 72, 64, lane);
        st_tile_tr(RSLOT(13) + 32 * tc * 72 + 32 * tr, 72, acc, lane);
    } else if (wq == 0) {
        const int blk = lane >> 4, cc = lane & 15;
        float tcol[16];
        for (int r2 = 0; r2 < 16; ++r2) { float v = (r2 == cc) ? 1.f : 0.f; for (int s2 = 0; s2 < r2; ++s2) v += LDG[blk * 256 + r2 * 16 + s2] * tcol[s2]; tcol[r2] = v; }
        for (int ob = 0; ob < 4; ++ob) {
            float x[16];
            for (int r2 = 0; r2 < 16; ++r2) { x[r2] = (ob == blk) ? tcol[r2] : 0.f; RSLOT(5)[(16 * ob + r2) * 72 + 16 * blk + cc] = f2bf(x[r2]); }
            u32x4 w0, w1; w0.x = pack2(x[0], x[1]); w0.y = pack2(x[2], x[3]); w0.z = pack2(x[4], x[5]); w0.w = pack2(x[6], x[7]); w1.x = pack2(x[8], x[9]); w1.y = pack2(x[10], x[11]); w1.z = pack2(x[12], x[13]); w1.w = pack2(x[14], x[15]);
            *(LQ u32x4*)(RSLOT(6) + (16 * blk + cc) * 72 + 16 * ob) = w0; *(LQ u32x4*)(RSLOT(6) + (16 * blk + cc) * 72 + 16 * ob + 8) = w1;
        }
    }
    M_SYNC();
    if (grp == 0) {
        f32x16 acc = zero16();
        mm_tile(acc, RSLOT(0) + 32 * tr * 72, 72, RSLOT(6) + 32 * tc * 72, 72, 64, lane);
        st_tile_tr(RSLOT(7) + 32 * tc * 72 + 32 * tr, 72, acc, lane);
    }
    M_SYNC();
    if (grp == 0) {
        f32x16 acc = zero16();
        mm_tile(acc, RSLOT(5) + 32 * tr * 72, 72, RSLOT(7) + 32 * tc * 72, 72, 64, lane);
        for (int e = 0; e < 16; ++e) acc[e] += bf2f(RSLOT(5)[(32 * tr + acc_row(e, hh)) * 72 + 32 * tc + r]);
        st_tile_rm(RSLOT(14) + 32 * tr * 72 + 32 * tc, 72, acc, lane);
        st_tile_tr(RSLOT(2) + 32 * tc * 72 + 32 * tr, 72, acc, lane);
    }
    M_SYNC();
    if (grp == 0) {
        f32x16 acc = zero16();
        mm_tile(acc, RSLOT(1) + 32 * tr * 72, 72, RSLOT(2) + 32 * tc * 72, 72, 64, lane);
        st_tile_tr(RSLOT(0) + 32 * tc * 72 + 32 * tr, 72, acc, lane);
    }
    M_SYNC();
    if (grp == 0) {
        f32x16 acc = zero16();
        mm_tile(acc, RSLOT(14) + 32 * tr * 72, 72, RSLOT(0) + 32 * tc * 72, 72, 64, lane);
        for (int e = 0; e < 16; ++e) acc[e] += bf2f(RSLOT(14)[(32 * tr + acc_row(e, hh)) * 72 + 32 * tc + r]);
        st_tile_rm(RSLOT(6) + 32 * tr * 72 + 32 * tc, 72, acc, lane);
    }
    M_SYNC();
    {
        f32x16 acc = zero16();
        mm_tile(acc, RSLOT(6) + 32 * tr * 72, 72, RSLOT(grp ? 13 : 9) + 32 * tc * 72, 72, 64, lane);
        st_tile_tr(RSLOT(grp ? 7 : 5) + 32 * tc * 72 + 32 * tr, 72, acc, lane);
    }
    M_SYNC();
    {
        const size_t tile = ((size_t)unit * 4 + wq) * 64 + lane;
        if (grp == 0) {
            f32x16 g = zero16(), q = zero16();
            mm_tile(g, RSLOT(5) + 32 * tr * 72, 72, RSLOT(10) + 32 * tc * 72, 72, 64, lane);
            mm_tile(q, RSLOT(5) + 32 * tr * 72, 72, RSLOT(3) + 32 * tc * 72, 72, 64, lane);
            for (int e = 0; e < 16; ++e) { const int j = 32 * tr + acc_row(e, hh), cl = 32 * tc + r; if (j == cl) g[e] += GC[cl]; q[e] += bf2f(RSLOT(8)[cl * 72 + j]); }
            dump_bf16(p.GTd + tile * 8, g); dump_bf16(p.Q1Td + tile * 8, q);
        } else {
            f32x16 ev = zero16(), q2 = zero16();
            mm_tile(ev, RSLOT(10) + 32 * tr * 72, 72, RSLOT(7) + 32 * tc * 72, 72, 64, lane); mm_tile(ev, RSLOT(11) + 32 * tr * 72, 72, RSLOT(4) + 32 * tc * 72, 72, 64, lane);
            mm_tile(q2, RSLOT(3) + 32 * tr * 72, 72, RSLOT(7) + 32 * tc * 72, 72, 64, lane); mm_tile(q2, RSLOT(12) + 32 * tr * 72, 72, RSLOT(4) + 32 * tc * 72, 72, 64, lane);
            dump_bf16(p.Ed + tile * 8, ev);
            for (int q4 = 0; q4 < 4; ++q4) *(f32x4v*)(p.Q2d + tile * 16 + 4 * q4) = (f32x4v){q2[4 * q4], q2[4 * q4 + 1], q2[4 * q4 + 2], q2[4 * q4 + 3]};
        }
    }
    M_SYNC();
}
MXD bf16x8 ldfrag(const unsigned* g) { return __builtin_bit_cast(bf16x8, *(const u32x4*)g); }
MXD void rwkv_chain(const RwkvP& p, int bh, int ih, int lane, int nchunk) {
    f32x16 H[2] = {zero16(), zero16()};
    for (int c = 0; c < nchunk; ++c) {
        const size_t unit = (size_t)bh * 32 + c;
        bf16x8 hb[2][2];
        for (int a = 0; a < 2; ++a) {
            u32x4 w0, w1; w0.x = pack2(H[a][0], H[a][1]); w0.y = pack2(H[a][2], H[a][3]); w0.z = pack2(H[a][4], H[a][5]); w0.w = pack2(H[a][6], H[a][7]);
            w1.x = pack2(H[a][8], H[a][9]); w1.y = pack2(H[a][10], H[a][11]); w1.z = pack2(H[a][12], H[a][13]); w1.w = pack2(H[a][14], H[a][15]);
            unsigned* hd = p.Hd + ((unit * 4 + a * 2 + ih) * 64 + lane) * 8; *(u32x4*)hd = w0; *(u32x4*)(hd + 4) = w1;
            hb[a][0] = __builtin_bit_cast(bf16x8, w0); hb[a][1] = __builtin_bit_cast(bf16x8, w1);
        }
        for (int A = 0; A < 2; ++A) {
            const unsigned* ed = p.Ed + ((unit * 4 + A * 2 + ih) * 64 + lane) * 8;
            f32x16 acc;
            for (int q = 0; q < 8; ++q) { const unsigned w = ed[q]; acc[2 * q] = bf2f((bf16)(w & 0xffffu)); acc[2 * q + 1] = bf2f((bf16)(w >> 16)); }
            for (int a = 0; a < 2; ++a) { const unsigned* gt = p.GTd + ((unit * 4 + a * 2 + A) * 64 + lane) * 8;
                acc = M_MFMA32(ldfrag(gt), hb[a][0], acc); acc = M_MFMA32(ldfrag(gt + 4), hb[a][1], acc); }
            H[A] = acc;
        }
    }
}
MXD void rwkv_out_unit(ldsp_t lds, const RwkvP& p, int unit2) {
    const int tid = M_TID, lane = tid & 63, wave = tid >> 6, wq = wave & 3, grp = wave >> 2;
    const int unit = 2 * unit2 + grp, c = unit & 31, h = (unit >> 5) & 7, b = unit >> 8, m0 = b * SEQ + c * 64;
    const int tt = wq >> 1, ih = wq & 1;
    LQ float* YL = (LQ float*)(lds + grp * 17408);
    {
        const float* q2 = p.Q2d + (((size_t)unit * 4 + wq) * 64 + lane) * 16;
        f32x16 acc; for (int e = 0; e < 16; ++e) acc[e] = q2[e];
        for (int a = 0; a < 2; ++a) {
            const unsigned* qa = p.Q1Td + (((size_t)unit * 4 + a * 2 + tt) * 64 + lane) * 8; const unsigned* hb = p.Hd + (((size_t)unit * 4 + a * 2 + ih) * 64 + lane) * 8;
            acc = M_MFMA32(ldfrag(qa), ldfrag(hb), acc); acc = M_MFMA32(ldfrag(qa + 4), ldfrag(hb + 4), acc);
        }
        st_tile_f32(YL + 32 * tt * 68 + 32 * ih, 68, acc, lane);
    }
    M_SYNC();
    {
        const int tg = tid & 255, t = tg >> 2, q = tg & 3, i0 = 16 * q;
        float y[16]; float s = 0.f, ss = 0.f;
        for (int e = 0; e < 16; ++e) { y[e] = YL[t * 68 + i0 + e]; s += y[e]; }
        s += M_SHFL_XOR(s, 1); s += M_SHFL_XOR(s, 2);
        const float mean = s * (1.f / 64.f);
        for (int e = 0; e < 16; ++e) { const float d = y[e] - mean; ss += d * d; }
        ss += M_SHFL_XOR(ss, 1); ss += M_SHFL_XOR(ss, 2);
        const float rstd = 1.f / sqrtf(ss * (1.f / 64.f) + GN_EPS);
        const size_t m = (size_t)(m0 + t); const float rk = p.RK[m * 8 + h];
        float v0[8], v1[8];
        shift8(p.proj, m * LDP, (c * 64 + t) > 0, CA_V + h * 64 + i0, p.mu, v0); shift8(p.proj, m * LDP, (c * 64 + t) > 0, CA_V + h * 64 + i0 + 8, p.mu, v1);
        const bf16x8 g0 = *(const bf16x8*)(p.proj + m * LDP + CG + h * 64 + i0), g1 = *(const bf16x8*)(p.proj + m * LDP + CG + h * 64 + i0 + 8);
        float o0[8], o1[8];
        for (int e = 0; e < 8; ++e) {
            const int ch = h * 64 + i0 + e;
            o0[e] = ((y[e] - mean) * rstd * p.ln_w[ch] + p.ln_b[ch] + rk * v0[e]) * silu_f(bf2f((bf16)g0[e]));
            o1[e] = ((y[8 + e] - mean) * rstd * p.ln_w[ch + 8] + p.ln_b[ch + 8] + rk * v1[e]) * silu_f(bf2f((bf16)g1[e]));
        }
        u32x4 w0, w1; w0.x = pack2(o0[0], o0[1]); w0.y = pack2(o0[2], o0[3]); w0.z = pack2(o0[4], o0[5]); w0.w = pack2(o0[6], o0[7]); w1.x = pack2(o1[0], o1[1]); w1.y = pack2(o1[2], o1[3]); w1.z = pack2(o1[4], o1[5]); w1.w = pack2(o1[6], o1[7]);
        *(u32x4*)(p.Y + m * DM + h * 64 + i0) = w0; *(u32x4*)(p.Y + m * DM + h * 64 + i0 + 8) = w1;
    }
    M_SYNC();
}
#ifndef HOST_TEST
constexpr int NWAVES = 8;
#ifndef MK_ONE_LAUNCH
#define MK_ONE_LAUNCH 1
#endif
constexpr int NPL = 6;
constexpr int NPHASES = 1 + DEPTH * NPL;

constexpr size_t MiB = 1u << 20;
constexpr size_t WS_CTL = 0, CTL_ZERO_BYTES = 1 * MiB;
constexpr size_t WS_WIN = 1 * MiB;
constexpr size_t WS_WOUT = WS_WIN + 48 * MiB;
constexpr size_t WS_XN = WS_WOUT + 16 * MiB;
constexpr size_t WS_PROJ = WS_XN + 32 * MiB;
constexpr size_t WS_O = WS_PROJ;
constexpr size_t WS_Y = WS_PROJ + 96 * MiB;
constexpr size_t WS_RW = WS_Y + 32 * MiB;
constexpr size_t RW_GT = 0, RW_E = 8 * MiB, RW_Q1T = 16 * MiB, RW_H = 24 * MiB, RW_Q2 = 32 * MiB, RW_RK = 48 * MiB;
constexpr size_t WS_POOLED = WS_RW + 112 * MiB;
constexpr size_t WS_VN = WS_POOLED + 16 * MiB;
constexpr size_t WS_TW = WS_VN + 16 * MiB;
constexpr size_t WS_AUX = WS_TW + 4 * MiB;
constexpr size_t AUX_POOLWT = 0, AUX_SGUWB = 131072, AUX_WUPT = 262144, AUX_AUPT = 327680, AUX_LAYER = 393216;
constexpr size_t WS_END = WS_AUX + 1 * MiB;
constexpr int CW_TMO = 0, CW_CODE = 1, CW_BAR = 4096;

constexpr int RING_OFF = 0, RING_BYTES = 131072;
constexpr int LDSCTL_OFF = 146944, MISC_OFF = LDSCTL_OFF + 320;
constexpr int LDS_BYTES = 147456;

#define GAS __attribute__((address_space(1)))
#define LAS __attribute__((address_space(3)))
typedef unsigned v4u __attribute__((ext_vector_type(4)));
typedef float f32x4 __attribute__((ext_vector_type(4)));
typedef GAS unsigned gu32;
#define RLX_AGENT __ATOMIC_RELAXED, __HIP_MEMORY_SCOPE_AGENT
#define LDS_WAIT() asm volatile("s_waitcnt lgkmcnt(0)" ::: "memory")
#define VM_WAIT() asm volatile("s_waitcnt vmcnt(0)" ::: "memory")
__device__ __forceinline__ unsigned pk2(float lo, float hi) { return (unsigned)f2bf(lo) | ((unsigned)f2bf(hi) << 16); }
#define XB_TMO      128
#define XB_XCNT(j)  (256  + 64 * (j))
#define XB_XSUB(j)  (1280 + 64 * (j))
#define XB_XGEN(j)  (2304 + 64 * (j))
#define XB_TOP      3328
#define XB_TOPGEN   3392
#define XCD_BAR_WORDS 3456
#define XB_SPIN_CAP (1u << 18)

__device__ __forceinline__ unsigned xb_ld(unsigned* p)              { return __hip_atomic_load(p, __ATOMIC_RELAXED, __HIP_MEMORY_SCOPE_AGENT); }
__device__ __forceinline__ unsigned xb_add(unsigned* p, unsigned v) { return __hip_atomic_fetch_add(p, v, __ATOMIC_RELAXED, __HIP_MEMORY_SCOPE_AGENT); }
__device__ __forceinline__ unsigned xb_xcc_id() { return (unsigned)__builtin_amdgcn_s_getreg((3 << 11) | 20) & 0xFu; }
#define XB_SPIN(cond, bar) do { unsigned _sp = 0; while (cond) { __builtin_amdgcn_s_sleep(1); \
    if ((++_sp & 255u) == 0u) { if (xb_ld(&(bar)[XB_TMO])) break; if (_sp > XB_SPIN_CAP) { atomicAdd(&(bar)[XB_TMO], 1u); break; } } } } while (0)

struct XcdBarrier {
    unsigned* bar; unsigned x;
    volatile LAS unsigned* st;
};

__device__ __forceinline__ XcdBarrier xcd_barrier_post(unsigned* bar, volatile LAS unsigned* st) {
    XcdBarrier b; b.bar = bar; b.x = xb_xcc_id(); b.st = st;
    if (threadIdx.x == 0) (void)xb_add(&bar[XB_XCNT(b.x)], 1u);
    return b;
}
__device__ __forceinline__ void xcd_barrier_complete(unsigned* bar, unsigned x, unsigned& nloc, unsigned& nx) {
    const unsigned G = gridDim.x * gridDim.y * gridDim.z;
    unsigned sum, cnt, mine, sp = 0u;
    for (;;) {
        sum = 0u; cnt = 0u; mine = 0u;
#pragma unroll
        for (unsigned j = 0; j < 16; ++j) { const unsigned c = xb_ld(&bar[XB_XCNT(j)]); sum += c; cnt += (c > 0u) ? 1u : 0u; mine = (j == x) ? c : mine; }
        if (sum == G) break;
        __builtin_amdgcn_s_sleep(1);
        if ((++sp & 255u) == 0u) { if (xb_ld(&bar[XB_TMO])) break; if (sp > XB_SPIN_CAP) { atomicAdd(&bar[XB_TMO], 1u); break; } }
    }
    nloc = mine > 0u ? mine : 1u; nx = cnt > 0u ? cnt : 1u;
}

__device__ __forceinline__ void xcd_barrier(const XcdBarrier& b) {
    asm volatile("s_waitcnt vmcnt(0)" ::: "memory");
    __syncthreads();
    if (threadIdx.x == 0) {
        unsigned* bar = b.bar;
        __builtin_amdgcn_s_waitcnt(0);
        unsigned nloc = b.st[0], nx = b.st[1];
        if (nloc == 0u) { xcd_barrier_complete(bar, b.x, nloc, nx); b.st[0] = nloc; b.st[1] = nx; }
        const unsigned old = xb_add(&bar[XB_XSUB(b.x)], 1u);
        const unsigned gen = old / nloc;
        if (old + 1u == (gen + 1u) * nloc) {
            __builtin_amdgcn_fence(__ATOMIC_RELEASE, "agent");
            asm volatile("s_waitcnt vmcnt(0)" ::: "memory");
            const unsigned og = xb_add(&bar[XB_TOP], 1u);
            const unsigned tg = og / nx;
            if (og + 1u == (tg + 1u) * nx) xb_add(&bar[XB_TOPGEN], 1u);
            else XB_SPIN(xb_ld(&bar[XB_TOPGEN]) == tg, bar);
            __builtin_amdgcn_fence(__ATOMIC_ACQUIRE, "agent");
            xb_add(&bar[XB_XGEN(b.x)], 1u);
            asm volatile("s_waitcnt vmcnt(0)" ::: "memory");
        } else {
            XB_SPIN(xb_ld(&bar[XB_XGEN(b.x)]) == gen, bar);
            __builtin_amdgcn_fence(__ATOMIC_ACQUIRE, "agent");
            asm volatile("s_waitcnt vmcnt(0)" ::: "memory");
        }
    }
    __syncthreads();
}
__device__ __forceinline__ float wave_sum(float v) {
#pragma unroll
    for (int o = 1; o < 64; o <<= 1) v += __shfl_xor(v, o);
    return v;
}
__device__ __forceinline__ void p0_transpose_item(const float* W, int K, int N, bf16* WT, LAS float* scr, int item, int lane) {
    const int nblk = N / 32, kb = item / nblk, nb = item % nblk, k0 = 64 * kb, n0 = 32 * nb;
#pragma unroll 8
    for (int i = 0; i < 32; ++i) { const int kk = 2 * i + (lane >> 5); scr[kk * 33 + (lane & 31)] = W[(size_t)(k0 + kk) * N + n0 + (lane & 31)]; }
    LDS_WAIT(); asm volatile("" ::: "memory");
    const int c = lane & 7;
#pragma unroll
    for (int j = 0; j < 4; ++j) { const int n = (lane >> 3) + 8 * j; const LAS float* s = scr + (8 * c) * 33 + n;
        v4u o; o.x = pk2(s[0 * 33], s[1 * 33]); o.y = pk2(s[2 * 33], s[3 * 33]); o.z = pk2(s[4 * 33], s[5 * 33]); o.w = pk2(s[6 * 33], s[7 * 33]);
        *(GAS v4u*)(WT + (size_t)(n0 + n) * K + k0 + 8 * c) = o; }
    LDS_WAIT(); asm volatile("" ::: "memory");
}
__device__ __forceinline__ void rms_row_to_bf16(const float* xrow, const float* w, bf16* orow, int lane) {
    const GAS f32x4* xr = (const GAS f32x4*)xrow + lane; const GAS f32x4* wr = (const GAS f32x4*)w + lane;
    f32x4 v[8]; float s = 0.f;
#pragma unroll
    for (int j = 0; j < 8; ++j) { v[j] = xr[64 * j]; s += (v[j].x * v[j].x + v[j].y * v[j].y) + (v[j].z * v[j].z + v[j].w * v[j].w); }
    const float rs = 1.f / sqrtf(wave_sum(s) * (1.f / DM) + NORM_EPS);
    GAS unsigned long long* o8 = (GAS unsigned long long*)orow + lane;
#pragma unroll
    for (int j = 0; j < 8; ++j) { const f32x4 ww = wr[64 * j];
        o8[64 * j] = (unsigned long long)pk2(v[j].x * rs * ww.x, v[j].y * rs * ww.y) | ((unsigned long long)pk2(v[j].z * rs * ww.z, v[j].w * rs * ww.w) << 32); }
}
__device__ __forceinline__ void post_row(const float* orow, const float* xin, const float* post_w, float* xout, const float* pre_w_next, bf16* xn, int lane) {
    const GAS f32x4* op = (const GAS f32x4*)orow + lane; const GAS f32x4* xp = (const GAS f32x4*)xin + lane; const GAS f32x4* pw = (const GAS f32x4*)post_w + lane;
    f32x4 v[8]; float s = 0.f;
#pragma unroll
    for (int j = 0; j < 8; ++j) { v[j] = op[64 * j]; s += (v[j].x * v[j].x + v[j].y * v[j].y) + (v[j].z * v[j].z + v[j].w * v[j].w); }
    const float rs = 1.f / sqrtf(wave_sum(s) * (1.f / DM) + NORM_EPS);
    float s2 = 0.f;
    GAS f32x4* xo = (GAS f32x4*)xout + lane;
#pragma unroll
    for (int j = 0; j < 8; ++j) { const f32x4 xx = xp[64 * j], ww = pw[64 * j]; v[j] = xx + v[j] * rs * ww; xo[64 * j] = v[j];
        s2 += (v[j].x * v[j].x + v[j].y * v[j].y) + (v[j].z * v[j].z + v[j].w * v[j].w); }
    if (pre_w_next) {
        const float rs2 = 1.f / sqrtf(wave_sum(s2) * (1.f / DM) + NORM_EPS);
        const GAS f32x4* wr = (const GAS f32x4*)pre_w_next + lane; GAS unsigned long long* o8 = (GAS unsigned long long*)xn + lane;
#pragma unroll
        for (int j = 0; j < 8; ++j) { const f32x4 ww = wr[64 * j];
            o8[64 * j] = (unsigned long long)pk2(v[j].x * rs2 * ww.x, v[j].y * rs2 * ww.y) | ((unsigned long long)pk2(v[j].z * rs2 * ww.z, v[j].w * rs2 * ww.w) << 32); }
    }
}

#ifndef GM
#define GM 3
#endif
#ifndef PHM
#define PHM 1023
#endif
struct Args { const float* in[21]; float* out; unsigned char* ws; int ph_lo, ph_hi; };
__device__ __forceinline__ int opaque_tid() { int t = threadIdx.x; asm volatile("" : "+v"(t)); return t; }
#define TID (opaque_tid())
#define LANE (TID & 63)
#define WAVE (__builtin_amdgcn_readfirstlane(TID >> 6))
#define GRIDN ((int)gridDim.x)
#define VCU ((GRIDN % 8 == 0) ? ((int)blockIdx.x % 8) * (GRIDN / 8) + (int)blockIdx.x / 8 : (int)blockIdx.x)
#define GTID (VCU * (NWAVES * 64) + TID)
#define GTN (GRIDN * NWAVES * 64)
#define GWV (VCU * NWAVES + WAVE)
#define NGWV (GRIDN * NWAVES)
__device__ __forceinline__ MixP make_mixp(const Args& args, int l) {
    unsigned char* ws = args.ws; MixP p;
    p.proj = (const bf16*)(ws + WS_PROJ); p.Y = (bf16*)(ws + WS_Y);
    p.poolWT = (const bf16*)(ws + WS_AUX + l * AUX_LAYER + AUX_POOLWT); p.sguWB = (const bf16*)(ws + WS_AUX + l * AUX_LAYER + AUX_SGUWB);
    p.pool_scale = args.in[16] + l * DBR; p.sgu_norm_w = args.in[17] + l * DBR; p.sgu_b = args.in[19] + l * 4 * 128; p.sinks = args.in[14] + l * 8;
    return p;
}
__device__ __forceinline__ RwkvP make_rwkvp(const Args& args, int l) {
    unsigned char* ws = args.ws; RwkvP p;
    p.proj = (const bf16*)(ws + WS_PROJ); p.Y = (bf16*)(ws + WS_Y);
    p.WupT = (const bf16*)(ws + WS_AUX + l * AUX_LAYER + AUX_WUPT); p.AupT = (const bf16*)(ws + WS_AUX + l * AUX_LAYER + AUX_AUPT);
    p.mu = args.in[4] + l * A_COLS; p.w0 = args.in[5] + l * DBR; p.a0 = args.in[7] + l * DBR; p.k_k = args.in[9] + l * DBR; p.k_a = args.in[10] + l * DBR; p.r_k = args.in[11] + l * DBR;
    p.ln_w = args.in[12] + l * DBR; p.ln_b = args.in[13] + l * DBR;
    p.GTd = (unsigned*)(ws + WS_RW + RW_GT); p.Ed = (unsigned*)(ws + WS_RW + RW_E); p.Q1Td = (unsigned*)(ws + WS_RW + RW_Q1T); p.Hd = (unsigned*)(ws + WS_RW + RW_H);
    p.Q2d = (float*)(ws + WS_RW + RW_Q2); p.RK = (float*)(ws + WS_RW + RW_RK);
    return p;
}
__global__ void __launch_bounds__(NWAVES * 64, 2) skel_fwd(Args args) {
    extern __shared__ __attribute__((aligned(16))) unsigned char lds[];
    LAS unsigned char* ldsp = (LAS unsigned char*)lds;
    for (int u = TID; u < (LDS_BYTES - LDSCTL_OFF) / 4; u += NWAVES * 64) ((LAS unsigned*)(ldsp + LDSCTL_OFF))[u] = 0u;
    __syncthreads();
#if MK_ONE_LAUNCH
    XcdBarrier bar = xcd_barrier_post((unsigned*)(args.ws + WS_CTL) + CW_BAR, (volatile LAS unsigned*)(ldsp + MISC_OFF) + 8);
#define GRID_BAR() xcd_barrier(bar)
#else
#define GRID_BAR() do { } while (0)
#endif
#define IN(k) (args.ph_lo <= (k) && (k) < args.ph_hi)
#define SEAM(k) do { if (IN((k) + 1)) GRID_BAR(); } while (0)

    if (IN(0)) {
        bf16* Win_t = (bf16*)(args.ws + WS_WIN); bf16* Wout_t = (bf16*)(args.ws + WS_WOUT); bf16* XN = (bf16*)(args.ws + WS_XN);
        const int lane = LANE, gw = GWV, NGW = NGWV;
        LAS float* scr = (LAS float*)(ldsp + RING_OFF + WAVE * 16384);
        constexpr int I_IN = (DM / 64) * (D_IN / 32), I_OUT = (DM / 64) * (DM / 32), NITEMS = DEPTH * (I_IN + I_OUT);
        for (int it = gw; it < NITEMS; it += NGW) {
            int r = it; const int l = r / (I_IN + I_OUT); r -= l * (I_IN + I_OUT);
            if (r < I_IN) p0_transpose_item(args.in[3] + (size_t)l * DM * D_IN, DM, D_IN, Win_t + (size_t)l * LDP * DM, scr, r, lane);
            else p0_transpose_item(args.in[20] + (size_t)l * DM * DM, DM, DM, Wout_t + (size_t)l * DM * DM, scr, r - I_IN, lane);
        }
        constexpr int PADV = (LDP - D_IN) * DM / 8;
        for (int i = GTID; i < DEPTH * PADV; i += GTN) { const int l = i / PADV, r = i % PADV; ((GAS v4u*)(Win_t + (size_t)l * LDP * DM + (size_t)D_IN * DM))[r] = (v4u){0u, 0u, 0u, 0u}; }
        for (int i = GTID; i < DEPTH * 4 * 128 * 128; i += GTN) {
            const int l = i >> 16, r = i & 65535, g = r >> 14, a = (r >> 7) & 127, c = r & 127;
            bf16* aux = (bf16*)(args.ws + WS_AUX + l * AUX_LAYER);
            aux[AUX_POOLWT / 2 + r] = f2bf(args.in[15][(size_t)l * 65536 + ((size_t)g * 128 + c) * 128 + a]);
            aux[AUX_SGUWB / 2 + r] = c <= a ? f2bf(args.in[18][(size_t)i]) : (bf16)0;
        }
        for (int i = GTID; i < DEPTH * 512 * 64; i += GTN) {
            const int l = i >> 15, r = i & 32767, c = r >> 6, j = r & 63;
            bf16* aux = (bf16*)(args.ws + WS_AUX + l * AUX_LAYER);
            aux[AUX_WUPT / 2 + r] = f2bf(args.in[6][(size_t)l * 32768 + j * 512 + c]); aux[AUX_AUPT / 2 + r] = f2bf(args.in[8][(size_t)l * 32768 + j * 512 + c]);
        }
        for (int m = gw; m < MTOK; m += NGW) rms_row_to_bf16(args.in[0] + (size_t)m * DM, args.in[1], XN + (size_t)m * DM, lane);
        SEAM(0);
    }
    for (int l = 0; l < DEPTH; ++l) {
        const int pb = 1 + l * NPL;
        if ((GM & 1) && IN(pb + 0)) {
            pg8::Gemm g{(const bf16*)(args.ws + WS_XN), (const bf16*)(args.ws + WS_WIN) + (size_t)l * LDP * DM, MTOK, LDP, DM}; pg8::StaticOrder S; S.init(MTOK, LDP, GRIDN, (int)blockIdx.x);
            pg8::EpiBf16<0> E{(bf16*)(args.ws + WS_PROJ), LDP, nullptr, 0, 0, 1.f};
            pg8::gemm_phase<pg8::EpiBf16<0>, pg8::StaticOrder, PG8_ALIGN, PG8_SP2>(ldsp + RING_OFF, g, S, E);
            SEAM(pb + 0);
        }
        if (IN(pb + 1)) { const RwkvP rp = make_rwkvp(args, l); for (int u = VCU; u < 1024; u += GRIDN) rwkv_r1_unit(ldsp, rp, u); SEAM(pb + 1); }
        if (IN(pb + 2)) {
            const int G = GRIDN, bx = (int)blockIdx.x;
            if (G >= 64 && bx < 32) { const RwkvP rp = make_rwkvp(args, l); const int wv = WAVE; if (wv < 2) rwkv_chain(rp, bx, wv, LANE, 32); }
            else {
                if (G < 64) { const RwkvP rp = make_rwkvp(args, l); const int wv = WAVE; for (int bh = bx; bh < 32; bh += G) if (wv < 2) rwkv_chain(rp, bh, wv, LANE, 32); __syncthreads(); }
                const MixP mp = make_mixp(args, l); const int first = (G >= 64) ? bx - 32 : bx, step = (G >= 64) ? G - 32 : G;
                for (int u = first; u < 768; u += step) { if (u < 256) swa_unit(ldsp, mp, u); else if (u < 512) pool_unit(ldsp, mp, u - 256); else sgu_unit(ldsp, mp, u - 512); }
            }
            SEAM(pb + 2);
        }
        if (IN(pb + 3)) { const RwkvP rp = make_rwkvp(args, l); for (int u = VCU; u < 512; u += GRIDN) rwkv_out_unit(ldsp, rp, u); SEAM(pb + 3); }
        if ((GM & 2) && IN(pb + 4)) {
            pg8::Gemm g{(const bf16*)(args.ws + WS_Y), (const bf16*)(args.ws + WS_WOUT) + (size_t)l * DM * DM, MTOK, DM, DM}; pg8::StaticOrder S; S.init(MTOK, DM, GRIDN, (int)blockIdx.x);
            pg8::EpiF32 E{(float*)(args.ws + WS_O), DM};
            pg8::gemm_phase<pg8::EpiF32, pg8::StaticOrder, PG8_ALIGN, PG8_SP2>(ldsp + RING_OFF, g, S, E);
            SEAM(pb + 4);
        }
        if (IN(pb + 5)) {
            const float* xin = (l == 0) ? args.in[0] : (const float*)args.out;
            const float* pre_next = (l + 1 < DEPTH) ? args.in[1] + (size_t)(l + 1) * DM : nullptr;
            const float* OB = (const float*)(args.ws + WS_O); bf16* XN = (bf16*)(args.ws + WS_XN);
            const int lane = LANE, NGW = NGWV;
            for (int m = GWV; m < MTOK; m += NGW)
                post_row(OB + (size_t)m * DM, xin + (size_t)m * DM, args.in[2] + (size_t)l * DM, args.out + (size_t)m * DM, pre_next, XN + (size_t)m * DM, lane);
            SEAM(pb + 5);
        }
    }
#undef IN
#undef SEAM
}

extern "C" void kernel_launch(void* const* d_in, const int* in_sizes, int n_in, void* d_out, int out_size, void* d_ws, size_t ws_size, hipStream_t stream) {
    static int grid = 0;
    if (grid == 0) {
        if (n_in != 21 || in_sizes[0] != MTOK * DM || out_size != MTOK * DM || ws_size < WS_END) {
            fprintf(stderr, "kernel_launch: shape/workspace mismatch: n_in %d in0 %d out %d ws %zu (need %zu); nothing launched\n", n_in, n_in > 0 ? in_sizes[0] : -1, out_size, ws_size, (size_t)WS_END); grid = -1; return; }
        int dev = 0, cus = 0;
        if (hipGetDevice(&dev) != hipSuccess || hipDeviceGetAttribute(&cus, hipDeviceAttributeMultiprocessorCount, dev) != hipSuccess) { grid = -1; return; }
        if (hipFuncSetAttribute((const void*)skel_fwd, hipFuncAttributeMaxDynamicSharedMemorySize, LDS_BYTES) != hipSuccess) { fprintf(stderr, "kernel_launch: hipFuncSetAttribute failed\n"); grid = -1; return; }
        (void)hipGetLastError();
        grid = cus;
    }
    if (grid < 0) return;
    if (hipMemsetAsync((char*)d_ws + WS_CTL, 0, CTL_ZERO_BYTES, stream) != hipSuccess) return;
    Args a{};
    for (int i = 0; i < 21; ++i) a.in[i] = (const float*)d_in[i];
    a.out = (float*)d_out; a.ws = (unsigned char*)d_ws;
#if MK_ONE_LAUNCH
    a.ph_lo = 0; a.ph_hi = NPHASES;
    hipLaunchKernelGGL(skel_fwd, dim3(grid), dim3(NWAVES * 64), LDS_BYTES, stream, a);
#else
    for (int ph = 0; ph < NPHASES; ++ph) { a.ph_lo = ph; a.ph_hi = ph + 1; hipLaunchKernelGGL(skel_fwd, dim3(grid), dim3(NWAVES * 64), LDS_BYTES, stream, a); }
#endif
}
#endif
```
